# Optimizing an MI355X kernel written in HIP

```python
import math
import jax
import jax.numpy as jnp
from jax import lax
import numpy as np

D_MODEL = 2048
BATCH = 4
SEQ = 4096
DEPTH = 4

CTX_LEN = 256
GRID_W = 64
D_MIX = D_MODEL
ATTN_W = D_MIX // 2
SSM_W = D_MIX // 4
GMLP_W = D_MIX - ATTN_W - SSM_W
HEAD_DIM = 64
N_HEADS = ATTN_W // HEAD_DIM
GQA_RATIO = 8
N_KV_HEADS = N_HEADS // GQA_RATIO
KV_W = N_KV_HEADS * HEAD_DIM
WINDOW = 128
ATTN_BLOCK = 128
ROPE_BASE = 10000.0
SSM_GROUP = 16
SSM_GROUPS = SSM_W // SSM_GROUP
SSM_STATE = 64
DT_MIN = 0.001
DT_MAX = 0.1
GMLP_CHUNK = 128
GMLP_GROUP_W = 128
GMLP_GROUPS = GMLP_W // GMLP_GROUP_W
D_FF = ((8 * D_MODEL // 3 + 255) // 256) * 256
CONV_W = 3
N_MOD = 6
NORM_EPS = 1e-6
OFF_K = ATTN_W
OFF_V = OFF_K + KV_W
OFF_S = OFF_V + KV_W
OFF_GU = OFF_S + SSM_W
OFF_GV = OFF_GU + GMLP_W
N_IN = OFF_GV + GMLP_W

kernel_name = 'hymba_style_s5_swa_gmlp_convffn_dit'


def rms_norm(x, g):
    xf = x.astype(jnp.float32)
    y = xf * lax.rsqrt(jnp.mean(xf * xf, axis=-1, keepdims=True) + NORM_EPS)
    return (y * g.astype(jnp.float32)).astype(x.dtype)


def layer_norm(x, g, b):
    xf = x.astype(jnp.float32)
    mu = jnp.mean(xf, axis=-1, keepdims=True)
    var = jnp.mean(jnp.square(xf - mu), axis=-1, keepdims=True)
    return ((xf - mu) * lax.rsqrt(var + NORM_EPS) * g.astype(jnp.float32) + b.astype(jnp.float32)).astype(x.dtype)


def modulate(h, shift, scale):
    return h * (1 + scale) + shift


def axial_rope_angles(rows):
    row = jnp.repeat(jnp.arange(rows), GRID_W)
    col = jnp.tile(jnp.arange(GRID_W), rows)
    n_freq = HEAD_DIM // 4
    inv_freq = ROPE_BASE ** (-jnp.arange(n_freq, dtype=jnp.float32) / n_freq)
    ang = jnp.stack([row, col], axis=-1).astype(jnp.float32)[:, :, None] * inv_freq
    return jnp.cos(ang), jnp.sin(ang)


def apply_rope(x, cos, sin):
    b, l, h, _ = x.shape
    xr = x.astype(jnp.float32).reshape(b, l, h, 2, 2, HEAD_DIM // 4)
    x1, x2 = xr[..., 0, :], xr[..., 1, :]
    cs, sn = cos[None, :, None], sin[None, :, None]
    out = jnp.stack([x1 * cs - x2 * sn, x1 * sn + x2 * cs], axis=-2)
    return out.reshape(b, l, h, HEAD_DIM).astype(x.dtype)


def window_attention(q, k, v, kc, vc, sink):
    b, l, _, _ = q.shape
    nb = l // ATTN_BLOCK
    n_c = kc.shape[1]
    scale = HEAD_DIM ** -0.5
    qb = q.reshape(b, nb, ATTN_BLOCK, N_KV_HEADS, GQA_RATIO, HEAD_DIM)
    pad = ((0, 0), (ATTN_BLOCK, ATTN_BLOCK), (0, 0), (0, 0))

    def band(t):
        tb = jnp.pad(t, pad).reshape(b, nb + 2, ATTN_BLOCK, N_KV_HEADS, HEAD_DIM)
        return jnp.concatenate([tb[:, :-2], tb[:, 1:-1], tb[:, 2:]], axis=2)

    kw, vw = band(k), band(v)
    s_win = jnp.einsum('bnqkgd,bnjkd->bnkgqj', qb, kw).astype(jnp.float32) * scale
    blk = jnp.arange(nb)[:, None, None]
    qpos = blk * ATTN_BLOCK + jnp.arange(ATTN_BLOCK)[None, :, None]
    kpos = (blk - 1) * ATTN_BLOCK + jnp.arange(3 * ATTN_BLOCK)[None, None, :]
    mask = (jnp.abs(kpos - qpos) <= WINDOW) & (kpos >= 0) & (kpos < l)
    s_win = jnp.where(mask[None, :, None, None], s_win, -jnp.inf)
    s_ctx = jnp.einsum('bnqkgd,bckd->bnkgqc', qb, kc).astype(jnp.float32) * scale
    s_sink = jnp.broadcast_to(sink.astype(jnp.float32).reshape(1, 1, N_KV_HEADS, GQA_RATIO, 1, 1),
                              s_win.shape[:-1] + (1,))
    p = jax.nn.softmax(jnp.concatenate([s_win, s_ctx, s_sink], axis=-1), axis=-1).astype(v.dtype)
    nw = 3 * ATTN_BLOCK
    o = (jnp.einsum('bnkgqj,bnjkd->bnqkgd', p[..., :nw], vw)
         + jnp.einsum('bnkgqc,bckd->bnqkgd', p[..., nw:nw + n_c], vc))
    return o.reshape(b, l, N_HEADS * HEAD_DIM)


def context_attention(qc, kc, vc, sink):
    b, n, _, _ = qc.shape
    qg = qc.reshape(b, n, N_KV_HEADS, GQA_RATIO, HEAD_DIM)
    s = jnp.einsum('bqkgd,bjkd->bkgqj', qg, kc).astype(jnp.float32) * HEAD_DIM ** -0.5
    s_sink = jnp.broadcast_to(sink.astype(jnp.float32).reshape(1, N_KV_HEADS, GQA_RATIO, 1, 1), s.shape[:-1] + (1,))
    p = jax.nn.softmax(jnp.concatenate([s, s_sink], axis=-1), axis=-1).astype(vc.dtype)
    o = jnp.einsum('bkgqj,bjkd->bqkgd', p[..., :n], vc)
    return o.reshape(b, n, N_HEADS * HEAD_DIM)


def s5_discretize(lam_re, lam_im, log_dt, b_re, b_im):
    lam_re = lam_re.astype(jnp.float32)
    lam_im = lam_im.astype(jnp.float32)
    dt = jnp.exp(log_dt.astype(jnp.float32))[:, None]
    mag = jnp.exp(lam_re * dt)
    a_re = mag * jnp.cos(lam_im * dt)
    a_im = mag * jnp.sin(lam_im * dt)
    den = lam_re * lam_re + lam_im * lam_im
    n_re = a_re - 1.0
    f_re = (n_re * lam_re + a_im * lam_im) / den
    f_im = (a_im * lam_re - n_re * lam_im) / den
    b_re = b_re.astype(jnp.float32)
    b_im = b_im.astype(jnp.float32)
    bb_re = f_re[..., None] * b_re - f_im[..., None] * b_im
    bb_im = f_re[..., None] * b_im + f_im[..., None] * b_re
    return a_re, a_im, bb_re, bb_im


def complex_affine_combine(e1, e2):
    a1r, a1i, b1r, b1i = e1
    a2r, a2i, b2r, b2i = e2
    return (a2r * a1r - a2i * a1i, a2r * a1i + a2i * a1r,
            a2r * b1r - a2i * b1i + b2r, a2r * b1i + a2i * b1r + b2i)


def s5_states(u, disc, h0, reverse):
    a_re, a_im, bb_re, bb_im = disc
    bu_re = jnp.einsum('gph,bngh->bngp', bb_re, u)
    bu_im = jnp.einsum('gph,bngh->bngp', bb_im, u)
    if h0 is not None:
        h_re, h_im = h0
        first = -1 if reverse else 0
        bu_re = bu_re.at[:, first].add(a_re * h_re - a_im * h_im)
        bu_im = bu_im.at[:, first].add(a_re * h_im + a_im * h_re)
    shape = bu_re.shape
    elems = (jnp.broadcast_to(a_re, shape), jnp.broadcast_to(a_im, shape), bu_re, bu_im)
    _, _, s_re, s_im = lax.associative_scan(complex_affine_combine, elems, reverse=reverse, axis=1)
    return s_re, s_im


def s5_readout(s_re, s_im, c_re, c_im):
    return jnp.einsum('ghp,bngp->bngh', c_re, s_re) - jnp.einsum('ghp,bngp->bngh', c_im, s_im)


def s5_glu(y, w_glu, b_glu):
    g = jax.nn.gelu(y)
    return g * jax.nn.sigmoid(g @ w_glu + b_glu)


def s5_mixer(u, uc, lam_re, lam_im, log_dt, b_re, b_im, c_re, c_im, d_skip, w_glu, b_glu, ctx_out):
    dtype = u.dtype
    bsz, n, _ = u.shape
    n_c = uc.shape[1]
    u4 = u.astype(jnp.float32).reshape(bsz, n, SSM_GROUPS, SSM_GROUP)
    uc4 = uc.astype(jnp.float32).reshape(bsz, n_c, SSM_GROUPS, SSM_GROUP)
    d4 = d_skip.astype(jnp.float32).reshape(SSM_GROUPS, SSM_GROUP)
    y = d4 * u4
    yc = d4 * uc4 if ctx_out else None
    for direction, rev in enumerate((False, True)):
        disc = s5_discretize(lam_re[direction], lam_im[direction], log_dt[direction], b_re[direction], b_im[direction])
        cr = c_re[direction].astype(jnp.float32)
        ci = c_im[direction].astype(jnp.float32)
        sc_re, sc_im = s5_states(uc4, disc, None, rev)
        end = 0 if rev else -1
        s_re, s_im = s5_states(u4, disc, (sc_re[:, end], sc_im[:, end]), rev)
        y = y + s5_readout(s_re, s_im, cr, ci)
        if ctx_out:
            yc = yc + s5_readout(sc_re, sc_im, cr, ci)
    out = s5_glu(y.reshape(bsz, n, SSM_W).astype(dtype), w_glu, b_glu)
    out_c = s5_glu(yc.reshape(bsz, n_c, SSM_W).astype(dtype), w_glu, b_glu) if ctx_out else None
    return out, out_c


def gmlp_spatial_gate(gu, gv, ln_g, ln_b, w_s, b_s):
    bsz, n, _ = gu.shape
    u = jax.nn.gelu(gu)
    v = layer_norm(jax.nn.gelu(gv), ln_g, ln_b)
    vch = v.reshape(bsz, n // GMLP_CHUNK, GMLP_CHUNK, GMLP_GROUPS, GMLP_GROUP_W)
    mixed = jnp.einsum('gij,bnjgc->bnigc', w_s, vch) + b_s.T[None, None, :, :, None]
    return u * mixed.reshape(bsz, n, GMLP_W)


def conv_ffn(h, w_up, conv_w, conv_b, w_down):
    n = h.shape[1]
    up = h @ w_up
    gate, val = up[..., :D_FF], up[..., D_FF:]
    half = CONV_W // 2
    gp = jnp.pad(gate, ((0, 0), (half, half), (0, 0)))
    gate = sum(gp[:, j:j + n] * conv_w[j] for j in range(CONV_W)) + conv_b
    return (jax.nn.silu(gate) * val) @ w_down


def setup_inputs(seed: int = 0) -> dict:
    key = jax.random.key(seed)
    ks = iter(jax.random.split(key, 40))

    def nrm(shape, std):
        return std * jax.random.normal(next(ks), shape, jnp.float32)

    x = nrm((BATCH, SEQ, D_MODEL), 1.0)
    c = nrm((BATCH, D_MODEL), 1.0)
    ctx = nrm((BATCH, CTX_LEN, D_MODEL), 1.0)
    c_ctx = nrm((D_MODEL,), 1.0)
    w_ada = nrm((DEPTH, D_MODEL, N_MOD * D_MODEL), 0.5 * D_MODEL ** -0.5)
    b_ada = nrm((DEPTH, N_MOD * D_MODEL), 0.02)
    g_mix = 1.0 + nrm((DEPTH, D_MODEL), 0.02)
    g_ffn = 1.0 + nrm((DEPTH, D_MODEL), 0.02)
    w_in = nrm((DEPTH, D_MODEL, N_IN), D_MODEL ** -0.5)
    w_out = nrm((DEPTH, D_MIX, D_MODEL), D_MIX ** -0.5)
    attn_sink = nrm((DEPTH, N_HEADS), 0.5)
    ssm_shape = (DEPTH, 2, SSM_GROUPS, SSM_STATE)
    ssm_lambda_re = -0.5 + nrm(ssm_shape, 0.01)
    ssm_lambda_im = math.pi * jnp.arange(SSM_STATE, dtype=jnp.float32) + nrm(ssm_shape, 0.01)
    ssm_log_dt = jax.random.uniform(next(ks), (DEPTH, 2, SSM_GROUPS), jnp.float32,
                                    minval=math.log(DT_MIN), maxval=math.log(DT_MAX))
    ssm_b_re = nrm((DEPTH, 2, SSM_GROUPS, SSM_STATE, SSM_GROUP), SSM_GROUP ** -0.5)
    ssm_b_im = nrm((DEPTH, 2, SSM_GROUPS, SSM_STATE, SSM_GROUP), SSM_GROUP ** -0.5)
    ssm_c_re = nrm((DEPTH, 2, SSM_GROUPS, SSM_GROUP, SSM_STATE), SSM_STATE ** -0.5)
    ssm_c_im = nrm((DEPTH, 2, SSM_GROUPS, SSM_GROUP, SSM_STATE), SSM_STATE ** -0.5)
    ssm_d = nrm((DEPTH, SSM_W), 1.0)
    ssm_w_glu = nrm((DEPTH, SSM_W, SSM_W), SSM_W ** -0.5)
    ssm_b_glu = nrm((DEPTH, SSM_W), 0.02)
    gmlp_ln_g = 1.0 + nrm((DEPTH, GMLP_W), 0.02)
    gmlp_ln_b = nrm((DEPTH, GMLP_W), 0.02)
    gmlp_w_s = nrm((DEPTH, GMLP_GROUPS, GMLP_CHUNK, GMLP_CHUNK), 0.5 * GMLP_CHUNK ** -0.5)
    gmlp_b_s = 1.0 + nrm((DEPTH, GMLP_GROUPS, GMLP_CHUNK), 0.02)
    ffn_w_up = nrm((DEPTH, D_MODEL, 2 * D_FF), D_MODEL ** -0.5)
    ffn_conv_w = nrm((DEPTH, CONV_W, D_FF), CONV_W ** -0.5)
    ffn_conv_b = nrm((DEPTH, D_FF), 0.02)
    ffn_w_down = nrm((DEPTH, D_FF, D_MODEL), D_FF ** -0.5)
    g_final = 1.0 + nrm((D_MODEL,), 0.02)
    return {'x': x, 'c': c, 'ctx': ctx, 'c_ctx': c_ctx, 'w_ada': w_ada, 'b_ada': b_ada,
            'g_mix': g_mix, 'g_ffn': g_ffn, 'w_in': w_in, 'w_out': w_out, 'attn_sink': attn_sink,
            'ssm_lambda_re': ssm_lambda_re, 'ssm_lambda_im': ssm_lambda_im, 'ssm_log_dt': ssm_log_dt,
            'ssm_b_re': ssm_b_re, 'ssm_b_im': ssm_b_im, 'ssm_c_re': ssm_c_re, 'ssm_c_im': ssm_c_im,
            'ssm_d': ssm_d, 'ssm_w_glu': ssm_w_glu, 'ssm_b_glu': ssm_b_glu,
            'gmlp_ln_g': gmlp_ln_g, 'gmlp_ln_b': gmlp_ln_b, 'gmlp_w_s': gmlp_w_s, 'gmlp_b_s': gmlp_b_s,
            'ffn_w_up': ffn_w_up, 'ffn_conv_w': ffn_conv_w, 'ffn_conv_b': ffn_conv_b, 'ffn_w_down': ffn_w_down,
            'g_final': g_final}


def reference(x, c, ctx, c_ctx, w_ada, b_ada, g_mix, g_ffn, w_in, w_out, attn_sink,
              ssm_lambda_re, ssm_lambda_im, ssm_log_dt, ssm_b_re, ssm_b_im, ssm_c_re, ssm_c_im,
              ssm_d, ssm_w_glu, ssm_b_glu, gmlp_ln_g, gmlp_ln_b, gmlp_w_s, gmlp_b_s,
              ffn_w_up, ffn_conv_w, ffn_conv_b, ffn_w_down, g_final):
    b, l, _ = x.shape
    n_c = ctx.shape[1]
    rows = l // GRID_W
    cos, sin = axial_rope_angles(rows)
    xc = ctx
    act_c = jax.nn.silu(c)
    act_cc = jax.nn.silu(c_ctx)
    for i in range(DEPTH):
        last = i == DEPTH - 1
        mod = (act_c @ w_ada[i] + b_ada[i])[:, None, :]
        mod_c = (act_cc @ w_ada[i] + b_ada[i])[None, None, :]
        shift_a, scale_a, gate_a, shift_f, scale_f, gate_f = jnp.split(mod, N_MOD, axis=-1)
        shift_ac, scale_ac, gate_ac, shift_fc, scale_fc, gate_fc = jnp.split(mod_c, N_MOD, axis=-1)

        h = modulate(rms_norm(x, g_mix[i]), shift_a, scale_a)
        hc = modulate(rms_norm(xc, g_mix[i]), shift_ac, scale_ac)
        z = h @ w_in[i]
        base = OFF_K if last else 0
        zc = hc @ (w_in[i][:, OFF_K:OFF_GU] if last else w_in[i])

        q = apply_rope(z[..., :OFF_K].reshape(b, l, N_HEADS, HEAD_DIM), cos, sin)
        k = apply_rope(z[..., OFF_K:OFF_V].reshape(b, l, N_KV_HEADS, HEAD_DIM), cos, sin)
        v = z[..., OFF_V:OFF_S].reshape(b, l, N_KV_HEADS, HEAD_DIM)
        kc = zc[..., OFF_K - base:OFF_V - base].reshape(b, n_c, N_KV_HEADS, HEAD_DIM)
        vc = zc[..., OFF_V - base:OFF_S - base].reshape(b, n_c, N_KV_HEADS, HEAD_DIM)
        o_attn = window_attention(q, k, v, kc, vc, attn_sink[i])

        o_ssm, o_ssm_c = s5_mixer(z[..., OFF_S:OFF_GU], zc[..., OFF_S - base:OFF_GU - base],
                                  ssm_lambda_re[i], ssm_lambda_im[i], ssm_log_dt[i], ssm_b_re[i], ssm_b_im[i],
                                  ssm_c_re[i], ssm_c_im[i], ssm_d[i], ssm_w_glu[i], ssm_b_glu[i], not last)

        o_gmlp = gmlp_spatial_gate(z[..., OFF_GU:OFF_GV], z[..., OFF_GV:], gmlp_ln_g[i], gmlp_ln_b[i],
                                   gmlp_w_s[i], gmlp_b_s[i])

        x = x + gate_a * (jnp.concatenate([o_attn, o_ssm, o_gmlp], axis=-1) @ w_out[i])
        x = x + gate_f * conv_ffn(modulate(rms_norm(x, g_ffn[i]), shift_f, scale_f),
                                  ffn_w_up[i], ffn_conv_w[i], ffn_conv_b[i], ffn_w_down[i])

        if not last:
            qc = zc[..., :OFF_K].reshape(b, n_c, N_HEADS, HEAD_DIM)
            o_attn_c = context_attention(qc, kc, vc, attn_sink[i])
            o_gmlp_c = gmlp_spatial_gate(zc[..., OFF_GU:OFF_GV], zc[..., OFF_GV:], gmlp_ln_g[i], gmlp_ln_b[i],
                                         gmlp_w_s[i], gmlp_b_s[i])
            xc = xc + gate_ac * (jnp.concatenate([o_attn_c, o_ssm_c, o_gmlp_c], axis=-1) @ w_out[i])
            xc = xc + gate_fc * conv_ffn(modulate(rms_norm(xc, g_ffn[i]), shift_fc, scale_fc),
                                         ffn_w_up[i], ffn_conv_w[i], ffn_conv_b[i], ffn_w_down[i])
    return rms_norm(x, g_final)
```

```cpp
#include <hip/hip_runtime.h>
#include <cstdio>
#include <cstdint>
namespace pg8 {
#define PG8_LAS __attribute__((address_space(3)))
typedef unsigned short bf16_t;
typedef short bf16x8 __attribute__((ext_vector_type(8)));
typedef float f32x4 __attribute__((ext_vector_type(4)));
typedef unsigned u32x4 __attribute__((ext_vector_type(4)));
constexpr int BM = 256, BK = 64, HALF = 128, HTB = HALF * BK * 2  , STAGE_BYTES = 8 * HTB, NXCD = 8, WGM = 4;

__host__ __device__ __forceinline__ int lds_byte(int r, int c) { const int st = (r >> 4) * 2 + (c >> 5), rr = r & 15, cc = c & 31, ob = rr * 64 + cc * 2; return st * 1024 + (ob ^ (((ob >> 9) & 1) << 5)); }
__host__ __device__ __forceinline__ void stage_rc(int b, int& R, int& C) { const int st = b / 1024, sb = b % 1024, swz = sb ^ (((sb >> 9) & 1) << 5); R = (st >> 1) * 16 + swz / 64; C = (st & 1) * 32 + (swz % 64) / 2; }
__host__ __device__ __forceinline__ int perm32(int rho) { const int n = rho >> 4, i = rho & 15; return 8 * (i >> 2) + 4 * n + (i & 3); }

struct Unit { int pm, pn, kb, nt, aux; };
struct Gemm { const bf16_t* A; const bf16_t* Bt; int M, N, K, ld; };

struct StaticOrder {
    int nM, nN, nwg, G, c;
    __host__ __device__ void init(int M, int N, int G_, int c_) { nM = M / BM; nN = N / BM; nwg = nM * nN; G = G_; c = c_; }
    __host__ __device__ bool next(int i, Unit& u) const {
        const long L = (long)i * G + c; if (L >= nwg) return false;
        int wgid = (int)L; { const int q = nwg / NXCD, r = nwg % NXCD, xcd = wgid % NXCD, off = wgid / NXCD; wgid = (xcd < r ? xcd * (q + 1) : r * (q + 1) + (xcd - r) * q) + off; }
        const int nig = WGM * nN, gid = wgid / nig, fm = gid * WGM, gsz = (nM - fm) < WGM ? (nM - fm) : WGM;
        u.pm = fm + ((wgid % nig) % gsz); u.pn = (wgid % nig) / gsz; u.kb = 0; u.nt = 0; u.aux = 0; return true;
    }
    __device__ __forceinline__ void a_ready(const Unit&) const {}
    __device__ __forceinline__ void done(const Unit&) const {}
};

__device__ __forceinline__ unsigned cvt_pk_bf16(float lo, float hi) { unsigned r; asm volatile("v_cvt_pk_bf16_f32 %0, %1, %2" : "=v"(r) : "v"(lo), "v"(hi)); return r; }
typedef float f32x2 __attribute__((ext_vector_type(2)));
template <int ACT  > struct EpiBf16 {
    static constexpr bool PERM = true, AFTER_DRAIN = false, PERM_A = false; static_assert(ACT == 0 || ACT == 1, "EpiBf16: ACT is 0 (none) or 1 (gelu_pk)");
    bf16_t* O; int ldc; const float* bias; int split_cols; size_t split_stride; float scale0;
    __device__ __forceinline__ void operator()(const f32x4 (&acc)[2][2][4][2], const Unit& u, int wr, int wc, int fr, int fq) const {
        const int row0 = u.pm * BM + wr * 64 + fr; int colt = u.pn * BM; bf16_t* base = O;
        float sc = 1.f; if (split_cols) { const int t = colt / split_cols; base += (size_t)t * split_stride; colt -= t * split_cols; if (t == 0) sc = scale0; }
        const int col0 = colt + wc * 32 + 8 * fq, bcol0 = u.pn * BM + wc * 32 + 8 * fq;
        f32x4 bv[2][2];
#pragma unroll
        for (int bj = 0; bj < 2; ++bj)
#pragma unroll
            for (int n = 0; n < 2; ++n) bv[bj][n] = bias ? *(const f32x4*)(bias + bcol0 + bj * HALF + 4 * n) : (f32x4){0.f, 0.f, 0.f, 0.f};
#pragma unroll
        for (int ai = 0; ai < 2; ++ai)
#pragma unroll
            for (int m = 0; m < 4; ++m) { bf16_t* rowp = base + (size_t)(row0 + ai * HALF + m * 16) * ldc + col0;
#pragma unroll
                for (int bj = 0; bj < 2; ++bj) { f32x4 v0 = acc[ai][bj][m][0] + bv[bj][0], v1 = acc[ai][bj][m][1] + bv[bj][1];
                                        v0 = v0 * sc; v1 = v1 * sc; u32x4 w; w.x = cvt_pk_bf16(v0[0], v0[1]); w.y = cvt_pk_bf16(v0[2], v0[3]); w.z = cvt_pk_bf16(v1[0], v1[1]); w.w = cvt_pk_bf16(v1[2], v1[3]);
                    *(u32x4*)(rowp + bj * HALF) = w; } }
    }
};
template <class Epi, class Sched, bool ALIGN_EPI = false, bool SP2 = false>
__device__ __forceinline__ void gemm_phase(PG8_LAS unsigned char* lds, const Gemm g, const Sched& S, const Epi& E, const int wave_id) {
    int tid_; asm volatile("v_mbcnt_lo_u32_b32 %0, -1, 0\n\tv_mbcnt_hi_u32_b32 %0, -1, %0" : "=v"(tid_)); tid_ += wave_id * 64;
    const int tid = tid_, wid = __builtin_amdgcn_readfirstlane(tid >> 6), lane = tid & 63, wr = wid >> 2, wc = wid & 3, fr = lane & 15, fq = lane >> 4;
    const int K = g.ld, nt0 = g.K / BK;
    unsigned voffA[2], voffB[2];
#pragma unroll
    for (int i = 0; i < 2; ++i) { int R, C; stage_rc(tid * 16 + i * 8192, R, C); const int Rb = Epi::PERM ? ((R & ~31) + perm32(R & 31)) : R;
        const int Ra = Epi::PERM_A ? ((R & ~63) + 4 * (R & 15) + ((R >> 4) & 3)) : R;
        voffA[i] = (unsigned)(Ra * K + C) * 2u; voffB[i] = (unsigned)(Rb * K + C) * 2u; }
    const size_t kstep = (size_t)(BK * 2);
    const size_t hstep = (size_t)HALF * K * 2;
    const size_t tstep = 2 * hstep;
    const unsigned ldsw = (unsigned)wid * 1024u;
    const int aoff = lds_byte(wr * 64 + fr, fq * 8), boff = lds_byte(wc * 32 + fr, fq * 8);
#define PG8_SA(b, h) (((b) * 2 + (h)) * HTB)
#define PG8_SB(b, h) ((4 + (b) * 2 + (h)) * HTB)
#define PG8_STAGE(bufoff, gbase, voff) do { _Pragma("unroll") for (int _i = 0; _i < 2; ++_i) \
        __builtin_amdgcn_global_load_lds((const unsigned*)((const char*)(gbase) + (voff)[_i]), (PG8_LAS unsigned*)(lds + (bufoff) + ldsw + _i * 8192), 16, 0, 0); } while (0)
#define PG8_LDA(dst, b, h) do { _Pragma("unroll") for (int m = 0; m < 4; ++m) _Pragma("unroll") for (int k = 0; k < 2; ++k) dst[m][k] = *(const PG8_LAS bf16x8*)(lds + PG8_SA(b, h) + aoff + m * 2048 + k * 1024); } while (0)
#define PG8_LDB(dst, b, h) do { _Pragma("unroll") for (int n = 0; n < 2; ++n) _Pragma("unroll") for (int k = 0; k < 2; ++k) dst[n][k] = *(const PG8_LAS bf16x8*)(lds + PG8_SB(b, h) + boff + n * 2048 + k * 1024); } while (0)
#define PG8_MMA(ai, bj, At, Bt) do { __builtin_amdgcn_s_setprio(1); _Pragma("unroll") for (int m = 0; m < 4; ++m) _Pragma("unroll") for (int n = 0; n < 2; ++n) _Pragma("unroll") for (int k = 0; k < 2; ++k) \
        acc[ai][bj][m][n] = __builtin_amdgcn_mfma_f32_16x16x32_bf16(Bt[n][k], At[m][k], acc[ai][bj][m][n], 0, 0, 0); __builtin_amdgcn_s_setprio(0); } while (0)
#define PG8_WAIT_V(n) asm volatile("s_waitcnt vmcnt(" #n ")" ::: "memory")
#define PG8_WAIT_L(n) asm volatile("s_waitcnt lgkmcnt(" #n ")" ::: "memory")
#define PG8_BAR __builtin_amdgcn_s_barrier()
#define PG8_SCHED __builtin_amdgcn_sched_barrier(0)
    Unit cur, nxt; int ui = 0;
    if (!S.next(0, cur)) return;
    f32x4 acc[2][2][4][2];
#pragma unroll
    for (int a = 0; a < 2; ++a)
#pragma unroll
        for (int b = 0; b < 2; ++b)
#pragma unroll
            for (int m = 0; m < 4; ++m)
#pragma unroll
                for (int n = 0; n < 2; ++n) acc[a][b][m][n] = (f32x4){0.f, 0.f, 0.f, 0.f};
    bf16x8 At[4][2], B0[2][2], B1[2][2];
    const char* cA = (const char*)g.A + (size_t)cur.pm * tstep + cur.kb; const char* cB = (const char*)g.Bt + (size_t)cur.pn * tstep + cur.kb;
    S.a_ready(cur);
    if constexpr (SP2) {
        PG8_STAGE(PG8_SB(0, 0), cB, voffB); PG8_STAGE(PG8_SB(0, 1), cB + hstep, voffB); PG8_STAGE(PG8_SA(0, 0), cA, voffA); PG8_STAGE(PG8_SA(0, 1), cA + hstep, voffA);
        if (wr == 1) PG8_BAR;
        PG8_WAIT_V(2); PG8_BAR;
        PG8_STAGE(PG8_SB(1, 0), cB + kstep, voffB); PG8_STAGE(PG8_SA(1, 0), cA + kstep, voffA); PG8_STAGE(PG8_SB(1, 1), cB + hstep + kstep, voffB);
        PG8_WAIT_V(6); PG8_BAR;
    } else {
        PG8_STAGE(PG8_SB(0, 0), cB, voffB); PG8_STAGE(PG8_SA(0, 0), cA, voffA); PG8_STAGE(PG8_SB(0, 1), cB + hstep, voffB); PG8_STAGE(PG8_SA(0, 1), cA + hstep, voffA);
        if (wr == 1) PG8_BAR;
        PG8_WAIT_V(4); PG8_BAR;
        PG8_STAGE(PG8_SB(1, 0), cB + kstep, voffB); PG8_STAGE(PG8_SA(1, 0), cA + kstep, voffA); PG8_STAGE(PG8_SB(1, 1), cB + hstep + kstep, voffB);
        PG8_WAIT_V(6); PG8_BAR;
    }
    for (;;) {
        const bool has_next = S.next(ui + 1, nxt); const int nt = cur.nt ? cur.nt : nt0;
        const char* nA = has_next ? (const char*)g.A + (size_t)nxt.pm * tstep + nxt.kb : cA; const char* nB = has_next ? (const char*)g.Bt + (size_t)nxt.pn * tstep + nxt.kb : cB;
        for (int t = 0; t < nt; t += 2) {
            const bool last = (t == nt - 2);
            const char* a1 = cA + (size_t)(t + 1) * kstep;
            const char* a2 = last ? nA : cA + (size_t)(t + 2) * kstep; const char* b2 = last ? nB : cB + (size_t)(t + 2) * kstep;
            const char* a3 = a2 + kstep; const char* b3 = b2 + kstep;
            if (last && has_next) S.a_ready(nxt);
            if constexpr (SP2) {
            PG8_LDB(B0, 0, 0); PG8_LDB(B1, 0, 1); PG8_SCHED; PG8_LDA(At, 0, 0); PG8_STAGE(PG8_SA(1, 1), a1 + hstep, voffA);
            PG8_WAIT_V(8); PG8_WAIT_L(0); PG8_BAR; PG8_MMA(0, 0, At, B0); PG8_MMA(0, 1, At, B1); PG8_BAR; PG8_SCHED;
            PG8_LDA(At, 0, 1); PG8_STAGE(PG8_SB(0, 0), b2, voffB); PG8_STAGE(PG8_SB(0, 1), b2 + hstep, voffB); PG8_STAGE(PG8_SA(0, 0), a2, voffA);
            PG8_WAIT_V(8); PG8_WAIT_L(0); PG8_BAR; PG8_MMA(1, 0, At, B0); PG8_MMA(1, 1, At, B1); PG8_BAR; PG8_SCHED;
            PG8_LDB(B0, 1, 0); PG8_LDB(B1, 1, 1); PG8_SCHED; PG8_LDA(At, 1, 0); PG8_STAGE(PG8_SA(0, 1), a2 + hstep, voffA);
            PG8_WAIT_V(8); PG8_WAIT_L(0); PG8_BAR; PG8_MMA(0, 0, At, B0); PG8_MMA(0, 1, At, B1); PG8_BAR; PG8_SCHED;
            PG8_LDA(At, 1, 1); PG8_STAGE(PG8_SB(1, 0), b3, voffB); PG8_STAGE(PG8_SB(1, 1), b3 + hstep, voffB); PG8_STAGE(PG8_SA(1, 0), a3, voffA);
            PG8_WAIT_V(8); PG8_WAIT_L(0); PG8_BAR; PG8_MMA(1, 0, At, B0); PG8_MMA(1, 1, At, B1); PG8_BAR; PG8_SCHED;
            } else {
            PG8_LDB(B0, 0, 0); PG8_SCHED; PG8_LDA(At, 0, 0); PG8_STAGE(PG8_SA(1, 1), a1 + hstep, voffA);
            PG8_WAIT_L(8); PG8_BAR; PG8_WAIT_L(0); PG8_MMA(0, 0, At, B0); PG8_BAR; PG8_SCHED;
            PG8_LDB(B1, 0, 1); PG8_STAGE(PG8_SB(0, 0), b2, voffB);
            PG8_BAR; PG8_WAIT_L(0); PG8_MMA(0, 1, At, B1); PG8_BAR;
            PG8_LDA(At, 0, 1); PG8_STAGE(PG8_SA(0, 0), a2, voffA);
            PG8_BAR; PG8_WAIT_L(0); PG8_MMA(1, 0, At, B0); PG8_BAR; PG8_SCHED;
            PG8_STAGE(PG8_SB(0, 1), b2 + hstep, voffB);
            PG8_WAIT_V(6); PG8_BAR; PG8_MMA(1, 1, At, B1); PG8_BAR;
            PG8_LDB(B0, 1, 0); PG8_SCHED; PG8_LDA(At, 1, 0); PG8_STAGE(PG8_SA(0, 1), a2 + hstep, voffA);
            PG8_WAIT_L(8); PG8_BAR; PG8_WAIT_L(0); PG8_MMA(0, 0, At, B0); PG8_BAR; PG8_SCHED;
            PG8_LDB(B1, 1, 1); PG8_STAGE(PG8_SB(1, 0), b3, voffB);
            PG8_BAR; PG8_WAIT_L(0); PG8_MMA(0, 1, At, B1); PG8_BAR;
            PG8_LDA(At, 1, 1); PG8_STAGE(PG8_SA(1, 0), a3, voffA);
            PG8_BAR; PG8_WAIT_L(0); PG8_MMA(1, 0, At, B0); PG8_BAR; PG8_SCHED;
            PG8_STAGE(PG8_SB(1, 1), b3 + hstep, voffB);
            PG8_WAIT_V(6); PG8_BAR; PG8_MMA(1, 1, At, B1); PG8_BAR;
            }
        }
        if constexpr (ALIGN_EPI) { if (wr == 0) PG8_BAR; }
        if constexpr (!Epi::AFTER_DRAIN) { E(acc, cur, wr, wc, fr, fq); S.done(cur); }
        if (!has_next) break;
#pragma unroll
        for (int a = 0; a < 2; ++a)
#pragma unroll
            for (int b = 0; b < 2; ++b)
#pragma unroll
                for (int m = 0; m < 4; ++m)
#pragma unroll
                    for (int n = 0; n < 2; ++n) acc[a][b][m][n] = (f32x4){0.f, 0.f, 0.f, 0.f};
        cur = nxt; cA = nA; cB = nB; ++ui;
        if constexpr (ALIGN_EPI) { if (wr == 1) PG8_BAR; }
    }
    PG8_WAIT_V(0);
    if constexpr (!ALIGN_EPI) { if (wr == 0) PG8_BAR; }
    PG8_BAR;
    if constexpr (Epi::AFTER_DRAIN) { E.fused(acc, cur, wr, wc, fr, fq, lds, wid, lane); S.done(cur); }
#undef PG8_SA
#undef PG8_SB
#undef PG8_STAGE
#undef PG8_LDA
#undef PG8_LDB
#undef PG8_MMA
#undef PG8_WAIT_V
#undef PG8_WAIT_L
#undef PG8_BAR
#undef PG8_SCHED
}
}

#ifndef PG8_SP2
#define PG8_SP2 true
#endif

constexpr int DM = 2048, NB = 4, SEQ = 4096, DEPTH = 4, CTXL = 256;
constexpr int ML = NB * SEQ, MC = NB * CTXL, MA = ML + MC;
constexpr int OFF_K = 1024, OFF_V = 1152, OFF_S = 1280, OFF_GU = 1792, OFF_GV = 2304, N_IN = 2816;
constexpr int SSM_W = 512, GMLP_W = 512, DFF = 5632, NUP = 2 * DFF, NMOD = 6 * DM, NSH = N_IN + NUP;
constexpr float NORM_EPS = 1e-6f;

constexpr size_t MiB = 1u << 20;
constexpr size_t WS_CTL = 0, CTL_ZERO_BYTES = 1 * MiB;
constexpr size_t WS_MOD = 1 * MiB;
constexpr size_t WS_SA = 2 * MiB;
constexpr size_t WS_SBBR = 3 * MiB, WS_SBBI = 4 * MiB;
constexpr size_t WS_ROPE = 5 * MiB;
constexpr size_t WS_GSV = 6 * MiB;
constexpr size_t WS_SHW = 7 * MiB;
constexpr size_t WS_SHWP = 9 * MiB;
constexpr size_t WS_SSQ = 44 * MiB;
constexpr size_t WS_APOW = 49 * MiB;
constexpr size_t WS_KL = 52 * MiB;
constexpr size_t WS_PT = 54 * MiB;
constexpr size_t WS_ET = 70 * MiB;
constexpr size_t WS_CS = 86 * MiB;
constexpr size_t WS_CY = 120 * MiB;
constexpr size_t WS_WSB = 137 * MiB;
constexpr size_t WS_W = 138 * MiB;
constexpr size_t W_IN_B = (size_t)N_IN * DM * 2, W_OUT_B = (size_t)DM * DM * 2, W_UP_B = (size_t)NUP * DM * 2, W_DN_B = (size_t)DM * DFF * 2, W_GLU_B = (size_t)SSM_W * SSM_W * 2;
constexpr size_t W_LAYER_B = W_IN_B + W_OUT_B + W_UP_B + W_DN_B + W_GLU_B;
constexpr size_t WS_XS = WS_W + ((DEPTH * W_LAYER_B + MiB - 1) / MiB) * MiB;
constexpr size_t WS_A = WS_XS + (size_t)MA * DM * 4;
constexpr size_t WS_Z = WS_A + (size_t)MA * DM * 2;
constexpr size_t WS_CAT = WS_Z + (size_t)MA * N_IN * 2;
constexpr size_t WS_GS = WS_CAT + (size_t)MA * DM * 2;
constexpr size_t WS_ACT = WS_GS + (size_t)MA * 512 * 2;
constexpr size_t WS_EG = WS_ACT + (size_t)MA * DFF * 2;
constexpr size_t WS_EV = WS_EG + (size_t)68 * 44 * 4 * 128 * 4;
constexpr size_t WS_SLAB = WS_EV + (size_t)68 * 44 * 2 * 128 * 4;
constexpr size_t WS_RSTD = WS_SLAB + (size_t)8 * MC * DM * 4;
constexpr size_t WS_END2 = WS_RSTD + (size_t)2 * MA * 4;
static_assert(WS_SHW + (size_t)DEPTH * 5 * NSH * 4 <= WS_SHWP && WS_SHWP + (size_t)32 * DEPTH * 5 * NSH * 4 <= WS_SSQ && WS_SSQ + (size_t)2 * MA * 32 * 4 <= WS_APOW, "d_ws map");
constexpr int CW_BAR = 4096;

constexpr int RING_OFF = 0, RING_BYTES = 131072;
constexpr int RT_OFF = 131072, EDG_OFF = RT_OFF + 1024;
constexpr int RT_OFF_UNUSED = 0;
constexpr int LDSCTL_OFF = 135168, MISC_OFF = LDSCTL_OFF + 320;
constexpr int ROPE_OFF = 136192, ROPE_STRIDE = 36;
constexpr int LDS_BYTES = 154624;
constexpr int NWAVES = 8;

#define GAS __attribute__((address_space(1)))
#define LAS __attribute__((address_space(3)))
typedef unsigned short bf16;
typedef unsigned v4u __attribute__((ext_vector_type(4)));
typedef unsigned v2u __attribute__((ext_vector_type(2)));
typedef float f32x4 __attribute__((ext_vector_type(4)));
typedef float f32x2 __attribute__((ext_vector_type(2)));
#define RLX_AGENT __ATOMIC_RELAXED, __HIP_MEMORY_SCOPE_AGENT
#define LDS_WAIT() asm volatile("s_waitcnt lgkmcnt(0)" ::: "memory")
#define VM_WAIT() asm volatile("s_waitcnt vmcnt(0)" ::: "memory")
#define WG_BAR() asm volatile("s_waitcnt lgkmcnt(0)\n\ts_barrier" ::: "memory")
typedef float f32x2_cv __attribute__((ext_vector_type(2))); typedef __bf16 bf16x2_cv __attribute__((ext_vector_type(2)));
__device__ __forceinline__ unsigned pk2(float lo, float hi) { f32x2_cv v = {lo, hi}; bf16x2_cv b = __builtin_convertvector(v, bf16x2_cv); return __builtin_bit_cast(unsigned, b); }
__device__ __forceinline__ unsigned f2bf(float f) { return pk2(f, 0.f) & 0xffffu; }
__device__ __forceinline__ float bflo(unsigned w) { return __uint_as_float(w << 16); }
__device__ __forceinline__ float bfhi(unsigned w) { return __uint_as_float(w & 0xffff0000u); }
__device__ __forceinline__ float bf2f(bf16 h) { return __uint_as_float((unsigned)h << 16); }
__device__ __forceinline__ float fexp(float x) { return __builtin_amdgcn_exp2f(x * 1.4426950408889634f); }
__device__ __forceinline__ float frcp(float x) { return __builtin_amdgcn_rcpf(x); }
__device__ __forceinline__ float gelu_tanh(float x) { const float u = 0.7978845608028654f * (x + 0.044715f * x * x * x); const float e = fexp(2.f * u); return x - x * frcp(e + 1.f); }
__device__ __forceinline__ float sigmoidf(float x) { return frcp(1.f + fexp(-x)); }
__device__ __forceinline__ float wave_sum(float v) {
    v += __int_as_float(__builtin_amdgcn_mov_dpp(__float_as_int(v), 0xB1, 0xf, 0xf, false));
    v += __int_as_float(__builtin_amdgcn_mov_dpp(__float_as_int(v), 0x4E, 0xf, 0xf, false));
    v += __int_as_float(__builtin_amdgcn_mov_dpp(__float_as_int(v), 0x141, 0xf, 0xf, false));
    v += __int_as_float(__builtin_amdgcn_mov_dpp(__float_as_int(v), 0x140, 0xf, 0xf, false));
    { auto r = __builtin_amdgcn_permlane16_swap(__float_as_uint(v), __float_as_uint(v), false, false); v = __uint_as_float(r[0]) + __uint_as_float(r[1]); }
    { auto r = __builtin_amdgcn_permlane32_swap(__float_as_uint(v), __float_as_uint(v), false, false); v = __uint_as_float(r[0]) + __uint_as_float(r[1]); }
    return v;
}

#define XB_TMO      128
#define XB_XCNT(j)  (256  + 64 * (j))
#define XB_XSUB(j)  (1280 + 64 * (j))
#define XB_XGEN(j)  (2304 + 64 * (j))
#define XB_TOP      3328
#define XB_TOPGEN   3392
#define XCD_BAR_WORDS 3456
#define XB_SPIN_CAP (1u << 18)

__device__ __forceinline__ unsigned xb_ld(unsigned* p)              { return __hip_atomic_load(p, __ATOMIC_RELAXED, __HIP_MEMORY_SCOPE_AGENT); }
__device__ __forceinline__ unsigned xb_add(unsigned* p, unsigned v) { return __hip_atomic_fetch_add(p, v, __ATOMIC_RELAXED, __HIP_MEMORY_SCOPE_AGENT); }
__device__ __forceinline__ unsigned xb_xcc_id() { return (unsigned)__builtin_amdgcn_s_getreg((3 << 11) | 20) & 0xFu; }
#define XB_SPIN(cond, bar) do { unsigned _sp = 0; while (cond) { __builtin_amdgcn_s_sleep(1); \
    if ((++_sp & 255u) == 0u) { if (xb_ld(&(bar)[XB_TMO])) break; if (_sp > XB_SPIN_CAP) { atomicAdd(&(bar)[XB_TMO], 1u); break; } } } } while (0)

struct XcdBarrier {
    unsigned* bar; unsigned x;
    volatile LAS unsigned* st;
};

__device__ __forceinline__ XcdBarrier xcd_barrier_post(unsigned* bar, volatile LAS unsigned* st) {
    XcdBarrier b; b.bar = bar; b.x = xb_xcc_id(); b.st = st;
    if (threadIdx.x == 0) (void)xb_add(&bar[XB_XCNT(b.x)], 1u);
    return b;
}
__device__ __forceinline__ void xcd_barrier_complete(unsigned* bar, unsigned x, unsigned& nloc, unsigned& nx) {
    const unsigned G = gridDim.x * gridDim.y * gridDim.z;
    unsigned sum, cnt, mine, sp = 0u;
    for (;;) {
        sum = 0u; cnt = 0u; mine = 0u;
#pragma unroll
        for (unsigned j = 0; j < 16; ++j) { const unsigned c = xb_ld(&bar[XB_XCNT(j)]); sum += c; cnt += (c > 0u) ? 1u : 0u; mine = (j == x) ? c : mine; }
        if (sum == G) break;
        __builtin_amdgcn_s_sleep(1);
        if ((++sp & 255u) == 0u) { if (xb_ld(&bar[XB_TMO])) break; if (sp > XB_SPIN_CAP) { atomicAdd(&bar[XB_TMO], 1u); break; } }
    }
    nloc = mine > 0u ? mine : 1u; nx = cnt > 0u ? cnt : 1u;
}

__device__ __forceinline__ void xcd_barrier(const XcdBarrier& b) {
    asm volatile("s_waitcnt vmcnt(0)" ::: "memory");
    __syncthreads();
    if (threadIdx.x == 0) {
        unsigned* bar = b.bar;
        __builtin_amdgcn_s_waitcnt(0);
        unsigned nloc = b.st[0], nx = b.st[1];
        if (nloc == 0u) { xcd_barrier_complete(bar, b.x, nloc, nx); b.st[0] = nloc; b.st[1] = nx; }
        const unsigned old = xb_add(&bar[XB_XSUB(b.x)], 1u);
        const unsigned gen = old / nloc;
        if (old + 1u == (gen + 1u) * nloc) {
            __builtin_amdgcn_fence(__ATOMIC_RELEASE, "agent");
            asm volatile("s_waitcnt vmcnt(0)" ::: "memory");
            const unsigned og = xb_add(&bar[XB_TOP], 1u);
            const unsigned tg = og / nx;
            if (og + 1u == (tg + 1u) * nx) xb_add(&bar[XB_TOPGEN], 1u);
            else XB_SPIN(xb_ld(&bar[XB_TOPGEN]) == tg, bar);
            __builtin_amdgcn_fence(__ATOMIC_ACQUIRE, "agent");
            xb_add(&bar[XB_XGEN(b.x)], 1u);
            asm volatile("s_waitcnt vmcnt(0)" ::: "memory");
        } else {
            XB_SPIN(xb_ld(&bar[XB_XGEN(b.x)]) == gen, bar);
            __builtin_amdgcn_fence(__ATOMIC_ACQUIRE, "agent");
            asm volatile("s_waitcnt vmcnt(0)" ::: "memory");
        }
    }
    __syncthreads();
}


enum { I_X = 0, I_C, I_CTX, I_CCTX, I_WADA, I_BADA, I_GMIX, I_GFFN, I_WIN, I_WOUT, I_SINK, I_LRE, I_LIM, I_LDT, I_BRE, I_BIM, I_CRE, I_CIM, I_SD, I_WGLU, I_BGLU,
       I_LNG, I_LNB, I_WS, I_BS, I_WUP, I_CW, I_CB, I_WDN, I_GFIN, N_INPUTS };
struct Args { const float* in[N_INPUTS]; float* out; unsigned char* ws; int ph_lo, ph_hi; };
static_assert(sizeof(Args) == N_INPUTS * 8 + 8 + 8 + 8, "Args has no padding");
struct Frame { LAS unsigned char* lds; int tid, lane, wave, G, bid, gw, NGW, gws, gt, NGT; };

__device__ __forceinline__ bf16* w_in_t(unsigned char* ws, int l) { return (bf16*)(ws + WS_W + (size_t)l * W_LAYER_B); }
__device__ __forceinline__ bf16* w_out_t(unsigned char* ws, int l) { return (bf16*)(ws + WS_W + (size_t)l * W_LAYER_B + W_IN_B); }
__device__ __forceinline__ bf16* w_up_t(unsigned char* ws, int l) { return (bf16*)(ws + WS_W + (size_t)l * W_LAYER_B + W_IN_B + W_OUT_B); }
__device__ __forceinline__ bf16* w_dn_t(unsigned char* ws, int l) { return (bf16*)(ws + WS_W + (size_t)l * W_LAYER_B + W_IN_B + W_OUT_B + W_UP_B); }
__device__ __forceinline__ bf16* w_glu_t(unsigned char* ws, int l) { return (bf16*)(ws + WS_W + (size_t)l * W_LAYER_B + W_IN_B + W_OUT_B + W_UP_B + W_DN_B); }
__device__ __forceinline__ int mod_row(int r) { return r < ML ? (r >> 12) : 4; }

struct TrItem { const float* W; bf16* WT; const float* sh; float* shp; int K, N, item, upperm; };
__device__ __forceinline__ void tr_load(const TrItem& d, int lane, float (&v)[32]) {
    const int nblk = d.N / 32, kb = d.item / nblk, nb = d.item % nblk, k0 = 64 * kb, n0 = 32 * nb;
#pragma unroll
    for (int i = 0; i < 32; ++i) v[i] = d.W[(size_t)(k0 + 2 * i + (lane >> 5)) * d.N + n0 + (lane & 31)];
}
__device__ __forceinline__ void tr_finish(const TrItem& d, LAS float* scr, int lane, const float (&v)[32]) {
    const int K = d.K, nblk = d.N / 32, kb = d.item / nblk, nb = d.item % nblk, k0 = 64 * kb, n0 = 32 * nb;
    const int n0o = !d.upperm ? n0 : (n0 < DFF ? 256 * (n0 >> 7) + (n0 & 127) : 256 * ((n0 - DFF) >> 7) + 128 + ((n0 - DFF) & 127));
#pragma unroll
    for (int i = 0; i < 32; ++i) scr[(2 * i + (lane >> 5)) * 33 + (lane & 31)] = v[i];
    if (d.sh) {
#pragma unroll
        for (int m = 0; m < 5; ++m) scr[64 * 33 + m * 64 + lane] = d.sh[(size_t)m * NMOD + k0 + lane]; }
    LDS_WAIT(); asm volatile("" ::: "memory");
    const int c = lane & 7;
#pragma unroll
    for (int j = 0; j < 4; ++j) { const int n = (lane >> 3) + 8 * j; const LAS float* s = scr + (8 * c) * 33 + n;
        v4u o; o.x = pk2(s[0 * 33], s[1 * 33]); o.y = pk2(s[2 * 33], s[3 * 33]); o.z = pk2(s[4 * 33], s[5 * 33]); o.w = pk2(s[6 * 33], s[7 * 33]);
        *(GAS v4u*)(d.WT + (size_t)(n0o + n) * K + k0 + 8 * c) = o; }
    if (d.sh) { const int n = lane & 31, hf = lane >> 5; float p[5] = {0.f, 0.f, 0.f, 0.f, 0.f};
#pragma unroll
        for (int i = 0; i < 32; ++i) { const float wv = scr[(32 * hf + i) * 33 + n];
#pragma unroll
            for (int m = 0; m < 5; ++m) p[m] += scr[64 * 33 + m * 64 + 32 * hf + i] * wv; }
#pragma unroll
        for (int m = 0; m < 5; ++m) { p[m] += __shfl_xor(p[m], 32); if (lane < 32) d.shp[(size_t)m * NSH + n0o + n] = p[m]; } }
    LDS_WAIT(); asm volatile("" ::: "memory");
}
__device__ __forceinline__ TrItem tr_decode_a(const Args& a, int it) {
    constexpr int I_OUT = (DM / 64) * (DM / 32), I_DN = (DFF / 64) * (DM / 32), I_GLU = (SSM_W / 64) * (SSM_W / 32), I_LA = I_OUT + I_DN + I_GLU;
    const int l = it / I_LA; int r = it % I_LA; unsigned char* ws = a.ws;
    if (r < I_OUT) return TrItem{a.in[I_WOUT] + (size_t)l * DM * DM, w_out_t(ws, l), nullptr, nullptr, DM, DM, r, 0}; r -= I_OUT;
    if (r < I_DN) return TrItem{a.in[I_WDN] + (size_t)l * DFF * DM, w_dn_t(ws, l), nullptr, nullptr, DFF, DM, r, 0}; r -= I_DN;
    return TrItem{a.in[I_WGLU] + (size_t)l * SSM_W * SSM_W, w_glu_t(ws, l), nullptr, nullptr, SSM_W, SSM_W, r, 0};
}
__device__ __forceinline__ TrItem tr_decode_b(const Args& a, int it) {
    constexpr int I_IN = (DM / 64) * (N_IN / 32), I_UP = (DM / 64) * (NUP / 32), I_LB = I_IN + I_UP;
    const int l = it / I_LB; int r = it % I_LB; unsigned char* ws = a.ws; const float* modl = (const float*)(ws + WS_MOD) + (size_t)l * 5 * NMOD; float* SHWP = (float*)(ws + WS_SHWP);
    if (r < I_IN) { const int kb = r / (N_IN / 32); return TrItem{a.in[I_WIN] + (size_t)l * DM * N_IN, w_in_t(ws, l), modl, SHWP + (size_t)(kb * DEPTH + l) * 5 * NSH, DM, N_IN, r, 0}; } r -= I_IN;
    const int kb = r / (NUP / 32); return TrItem{a.in[I_WUP] + (size_t)l * DM * NUP, w_up_t(ws, l), modl + 3 * DM, SHWP + (size_t)(kb * DEPTH + l) * 5 * NSH + N_IN, DM, NUP, r, 1};
}
template <bool LIST_B> __device__ __forceinline__ void tr_run(const Frame& F, const Args& a, LAS float* scr, int nitems) {
#pragma unroll 1
    for (int it = F.gw; it < nitems; it += 2 * F.NGW) {
        const int itb = it + F.NGW; const bool hb = itb < nitems; float v0[32], v1[32];
        tr_load(LIST_B ? tr_decode_b(a, it) : tr_decode_a(a, it), F.lane, v0);
        if (hb) tr_load(LIST_B ? tr_decode_b(a, itb) : tr_decode_a(a, itb), F.lane, v1);
        tr_finish(LIST_B ? tr_decode_b(a, it) : tr_decode_a(a, it), scr, F.lane, v0);
        if (hb) tr_finish(LIST_B ? tr_decode_b(a, itb) : tr_decode_a(a, itb), scr, F.lane, v1);
    }
}
__device__ __forceinline__ void p0a_conv(const Frame& F, const Args& a) {
    { constexpr int I_LA = (DM / 64) * (DM / 32) + (DFF / 64) * (DM / 32) + (SSM_W / 64) * (SSM_W / 32);
      tr_run<false>(F, a, (LAS float*)(F.lds + RING_OFF + 65536 + F.wave * 8704), DEPTH * I_LA); }
}
__device__ __forceinline__ void p0a(const Frame& F, const Args& a) {
    unsigned char* ws = a.ws;
    { LAS float* SC = (LAS float*)(F.lds); LAS f32x4* PP = (LAS f32x4*)(F.lds + 40960); float* MOD = (float*)(ws + WS_MOD);
      const float* cc = a.in[I_C]; const float* cx = a.in[I_CCTX]; const float* wada = a.in[I_WADA]; const float* bada = a.in[I_BADA];
      for (int i = F.tid; i < 5 * DM; i += NWAVES * 64) { const int m = i >> 11, k = i & (DM - 1); const float c = m < 4 ? cc[m * DM + k] : cx[k]; SC[i] = c * sigmoidf(c); }
      WG_BAR();
#pragma unroll 1
      for (int it = F.bid; it < DEPTH * 64; it += F.G) { const int l = it >> 6, nb = it & 63, k0 = 256 * F.wave;
          const int ln = F.lane < 48 ? F.lane : 47;
          const f32x4* w = (const f32x4*)(wada + ((size_t)l * DM + k0) * NMOD + nb * 192) + ln; f32x4 acc[5];
#pragma unroll
          for (int m = 0; m < 5; ++m) acc[m] = (f32x4){0.f, 0.f, 0.f, 0.f};
#pragma unroll 32
          for (int kk = 0; kk < 256; ++kk) { const f32x4 wv = __builtin_nontemporal_load(w + (size_t)kk * (NMOD / 4));
#pragma unroll
              for (int m = 0; m < 5; ++m) acc[m] = acc[m] + wv * SC[m * DM + k0 + kk]; }
#pragma unroll
          for (int m = 0; m < 5; ++m) PP[(F.wave * 5 + m) * 64 + F.lane] = acc[m];
          WG_BAR();
          if (F.tid < 320 && (F.tid & 63) < 48) { const int m = F.tid >> 6, nn = F.tid & 63; f32x4 s = *(const f32x4*)(bada + l * NMOD + nb * 192 + 4 * nn);
#pragma unroll
              for (int w8 = 0; w8 < 8; ++w8) s = s + PP[(w8 * 5 + m) * 64 + nn];
              *(f32x4*)(MOD + (size_t)(l * 5 + m) * NMOD + nb * 192 + 4 * nn) = s; }
          WG_BAR();
      } }
    { float* SA = (float*)(ws + WS_SA); float* SBR = (float*)(ws + WS_SBBR); float* SBI = (float*)(ws + WS_SBBI); float* APW = (float*)(ws + WS_APOW);
      for (int it = F.gt; it < DEPTH * 2 * 32 * 64 * 18; it += F.NGT) { const int i = it / 18, k = it % 18;
          const double lr = a.in[I_LRE][i], li = a.in[I_LIM][i], dt = exp((double)a.in[I_LDT][i >> 6]);
          if (k < 17) { const double mk = exp(lr * dt * k), an = li * dt * k; APW[(size_t)i * 34 + 2 * k] = (float)(mk * cos(an)); APW[(size_t)i * 34 + 2 * k + 1] = (float)(mk * sin(an)); }
          else { const double mag = exp(lr * dt), ar = mag * cos(li * dt), ai = mag * sin(li * dt); const double den = lr * lr + li * li, nr = ar - 1.0;
              const double fr = (nr * lr + ai * li) / den, fi = (ai * lr - nr * li) / den;
              SA[2 * i] = (float)ar; SA[2 * i + 1] = (float)ai;
#pragma unroll 4
              for (int h = 0; h < 16; ++h) { const double br = a.in[I_BRE][(size_t)i * 16 + h], bi = a.in[I_BIM][(size_t)i * 16 + h];
                  SBR[(size_t)i * 16 + h] = (float)(fr * br - fi * bi); SBI[(size_t)i * 16 + h] = (float)(fr * bi + fi * br); } }
      } }
    { const float* wsf = a.in[I_WS]; bf16* WSB = (bf16*)(ws + WS_WSB); for (int i = F.gt; i < DEPTH * 4 * 128 * 128; i += F.NGT) WSB[i] = (bf16)f2bf(wsf[i]); }
    { float* RC = (float*)(ws + WS_ROPE); float* RS = RC + SEQ * 32;
      for (int i = F.gt; i < SEQ * 32; i += F.NGT) { const int t = i >> 5, j = i & 31, ax = j >> 4, f = j & 15;
          const float inv = powf(10000.f, -(float)f / 16.f); const float ang = (float)(ax == 0 ? (t >> 6) : (t & 63)) * inv;
          RC[i] = cosf(ang); RS[i] = sinf(ang); } }
}

__device__ __forceinline__ void p0b_conv(const Frame& F, const Args& a) {
    unsigned char* ws = a.ws; const float* MOD = (const float*)(ws + WS_MOD); float* SHWP = (float*)(ws + WS_SHWP);
    { constexpr int I_LB = (DM / 64) * (N_IN / 32) + (DM / 64) * (NUP / 32);
      tr_run<true>(F, a, (LAS float*)(F.lds + RING_OFF + F.wave * 16384), DEPTH * I_LB); }
}
__device__ __forceinline__ void p0b(const Frame& F, const Args& a) {
    unsigned char* ws = a.ws; const float* MOD = (const float*)(ws + WS_MOD);
    { float* GSV = (float*)(ws + WS_GSV);
      for (int i = F.gt; i < DEPTH * 2 * 5 * DM; i += F.NGT) { const int k = i & (DM - 1), m = (i >> 11) % 5, w = (i / (5 * DM)) & 1, l = i / (10 * DM);
          GSV[i] = (w ? a.in[I_GFFN][l * DM + k] : a.in[I_GMIX][l * DM + k]) * (1.f + MOD[(size_t)(l * 5 + m) * NMOD + (w ? 4 : 1) * DM + k]); } }
    { bf16* A = (bf16*)(ws + WS_A);
      for (int r = F.gw; r < MA; r += F.NGW) {
          const float* xrow = r < ML ? a.in[I_X] + (size_t)r * DM : a.in[I_CTX] + (size_t)(r - ML) * DM;
          const f32x4* xr = (const f32x4*)xrow + F.lane; const float* gm = a.in[I_GMIX]; const float* sc = MOD + (size_t)mod_row(r) * NMOD + DM; v2u* o = (v2u*)(A + (size_t)r * DM) + F.lane; float s = 0.f;
          f32x4 v[8], gg[8];
#pragma unroll
          for (int j = 0; j < 8; ++j) { v[j] = xr[64 * j]; gg[j] = *(const f32x4*)(gm + 4 * F.lane + 256 * j) * (*(const f32x4*)(sc + 4 * F.lane + 256 * j) + 1.f); }
#pragma unroll
          for (int j = 0; j < 8; ++j) { s += (v[j].x * v[j].x + v[j].y * v[j].y) + (v[j].z * v[j].z + v[j].w * v[j].w); const f32x4 y = v[j] * gg[j]; v2u w; w.x = pk2(y.x, y.y); w.y = pk2(y.z, y.w); o[64 * j] = w; }
          s = wave_sum(s); if (F.lane == 0) ((float*)(ws + WS_RSTD))[r] = 1.f / sqrtf(s * (1.f / DM) + NORM_EPS);
      } }
}
__device__ __forceinline__ void p0c(const Frame& F, const Args& a) {
    unsigned char* ws = a.ws;
    { const float* SHWP = (const float*)(ws + WS_SHWP); float* SHW = (float*)(ws + WS_SHW);
      for (int i = F.gt; i < DEPTH * 5 * NSH; i += F.NGT) { float s = 0.f;
#pragma unroll 8
          for (int kb = 0; kb < 32; ++kb) s += SHWP[(size_t)kb * DEPTH * 5 * NSH + i];
          SHW[i] = s; } }

}

__device__ __forceinline__ void conv_fixup(const Frame& F, const Args& a, int l) {
    const float* EG = (const float*)(a.ws + WS_EG); const float* EV = (const float*)(a.ws + WS_EV); bf16* ACT = (bf16*)(a.ws + WS_ACT); const float* cw = a.in[I_CW] + (size_t)l * 3 * DFF; const float* cb = a.in[I_CB] + (size_t)l * DFF;
    for (int idx = F.gt; idx < 60 * 2 * DFF; idx += F.NGT) { const int c = idx % DFF, wh = (idx / DFF) & 1, bi = idx / (2 * DFF); const int pm = 16 * (bi / 15) + (bi % 15), pn = c >> 7, cc = c & 127;
        const float* ep = EG + ((size_t)(pm * 44 + pn) * 4) * 128 + cc; const float* en = EG + ((size_t)((pm + 1) * 44 + pn) * 4) * 128 + cc;
        float gm, g0, gp, vv;
        if (wh == 0) { gm = ep[2 * 128]; g0 = ep[3 * 128]; gp = en[0]; vv = EV[((size_t)(pm * 44 + pn) * 2 + 1) * 128 + cc]; }
        else { gm = ep[3 * 128]; g0 = en[0]; gp = en[128]; vv = EV[((size_t)((pm + 1) * 44 + pn) * 2) * 128 + cc]; }
        const float pre = cw[c] * gm + cw[DFF + c] * g0 + cw[2 * DFF + c] * gp + cb[c];
        ACT[(size_t)(256 * (pm + 1) - 1 + wh) * DFF + c] = (bf16)f2bf(pre * sigmoidf(pre) * vv); }
}
__device__ __forceinline__ void lat_rstd(const Frame& F, const Args& a, int stage) {
    const float* SSQ = (const float*)(a.ws + WS_SSQ) + (stage == 0 ? (size_t)MA * 32 : 0); float* RST = (float*)(a.ws + WS_RSTD) + (stage == 0 ? MA : 0);
    for (int r = F.gt; r < ML; r += F.NGT) { const f32x4* p = (const f32x4*)(SSQ + (size_t)r * 32); f32x4 s = p[0];
#pragma unroll
        for (int j = 1; j < 8; ++j) s = s + p[j];
        RST[r] = 1.f / sqrtf(((s.x + s.y) + (s.z + s.w)) * (1.f / DM) + NORM_EPS); }
}
__device__ __forceinline__ void ctx_reduce(const Frame& F, const Args& a, int l, int stage) {
    const float* SL = (const float*)(a.ws + WS_SLAB); float* XS = (float*)(a.ws + WS_XS); bf16* A = (bf16*)(a.ws + WS_A); const int nks = 8;
    const float* gate = (const float*)(a.ws + WS_MOD) + (size_t)(l * 5 + 4) * NMOD + (stage == 0 ? 2 : 5) * DM;
    const float* gsn = (const float*)(a.ws + WS_GSV) + (size_t)((stage == 0 ? l * 2 + 1 : (l + 1) * 2) * 5 + 4) * DM;
    float* RST = (float*)(a.ws + WS_RSTD) + (stage == 0 ? MA : 0);
    for (int r = F.gw; r < MC; r += F.NGW) { const size_t row = (size_t)ML + r;
        const float* xr = (l == 0 && stage == 0) ? a.in[I_CTX] + (size_t)r * DM : XS + row * DM; float s = 0.f;
        f32x4 pp[8], xx[8];
#pragma unroll
        for (int j = 0; j < 8; ++j) { const int k = 4 * F.lane + 256 * j; pp[j] = *(const f32x4*)(SL + (size_t)r * DM + k); xx[j] = *(const f32x4*)(xr + k);
            for (int ks = 1; ks < nks; ++ks) pp[j] = pp[j] + *(const f32x4*)(SL + ((size_t)ks * MC + r) * DM + k); }
#pragma unroll
        for (int j = 0; j < 8; ++j) { const int k = 4 * F.lane + 256 * j; const f32x4 p = pp[j];
            const f32x4 x = xx[j] + *(const f32x4*)(gate + k) * p; *(f32x4*)(XS + row * DM + k) = x; s += (x.x * x.x + x.y * x.y) + (x.z * x.z + x.w * x.w);
            const f32x4 y = x * *(const f32x4*)(gsn + k); v2u w; w.x = pk2(y.x, y.y); w.y = pk2(y.z, y.w); *(v2u*)(A + row * DM + k) = w; }
        s = wave_sum(s); if (F.lane == 0) RST[row] = 1.f / sqrtf(s * (1.f / DM) + NORM_EPS);
    }
}
__device__ __forceinline__ void final_norm(const Frame& F, const Args& a) {
    const float* XS = (const float*)(a.ws + WS_XS); const float* g = a.in[I_GFIN];
    f32x4 gg[8];
#pragma unroll
    for (int j = 0; j < 8; ++j) gg[j] = *(const f32x4*)(g + 4 * F.lane + 256 * j);
#pragma unroll 1
    for (int r = F.gw; r < ML; r += 2 * F.NGW) {
        const int r1 = r + F.NGW < ML ? r + F.NGW : r; f32x4 v0[8], v1[8]; float s0 = 0.f, s1 = 0.f;
        const f32x4* x0 = (const f32x4*)(XS + (size_t)r * DM) + F.lane; const f32x4* x1 = (const f32x4*)(XS + (size_t)r1 * DM) + F.lane;
#pragma unroll
        for (int j = 0; j < 8; ++j) { v0[j] = x0[64 * j]; v1[j] = x1[64 * j]; }
#pragma unroll
        for (int j = 0; j < 8; ++j) { s0 += (v0[j].x * v0[j].x + v0[j].y * v0[j].y) + (v0[j].z * v0[j].z + v0[j].w * v0[j].w); s1 += (v1[j].x * v1[j].x + v1[j].y * v1[j].y) + (v1[j].z * v1[j].z + v1[j].w * v1[j].w); }
        const float rs0 = 1.f / sqrtf(wave_sum(s0) * (1.f / DM) + NORM_EPS), rs1 = 1.f / sqrtf(wave_sum(s1) * (1.f / DM) + NORM_EPS);
        f32x4* o0 = (f32x4*)(a.out + (size_t)r * DM) + F.lane; f32x4* o1 = (f32x4*)(a.out + (size_t)r1 * DM) + F.lane;
#pragma unroll
        for (int j = 0; j < 8; ++j) { o0[64 * j] = v0[j] * rs0 * gg[j]; o1[64 * j] = v1[j] * rs1 * gg[j]; }
    }
}
namespace att {
typedef short bf16x8 __attribute__((ext_vector_type(8)));
typedef short s16x4 __attribute__((ext_vector_type(4)));
typedef float f32x16 __attribute__((ext_vector_type(16)));
typedef unsigned u32x4 __attribute__((ext_vector_type(4)));
constexpr int SLOTB = 8192, LDS_K = 0, LDS_V = 3 * SLOTB, LDS_WS = 6 * SLOTB, LDS_OST = LDS_WS + 8 * 64 * 4, LDS_TOTAL = LDS_OST + 8 * 4096;
constexpr float C2 = 0.125f * 1.4426950408889634f, LOG2E = 1.4426950408889634f;
__device__ __forceinline__ int crow(int r, int hi) { return (r & 3) + 8 * (r >> 2) + 4 * hi; }
__device__ __forceinline__ void glds16(const void* gsrc, unsigned lds_dst) { unsigned keep;
    asm volatile("s_mov_b32 %0, m0\n\ts_mov_b32 m0, %2\n\ts_nop 0\n\tglobal_load_lds_dwordx4 %1, off\n\ts_mov_b32 m0, %0" : "=&s"(keep) : "v"(gsrc), "s"(lds_dst) : "memory"); }
typedef float f32x2_t __attribute__((ext_vector_type(2))); typedef __bf16 bf16x2_t __attribute__((ext_vector_type(2)));
__device__ __forceinline__ unsigned cvtpk_s(float lo, float hi) { f32x2_t v = {lo, hi}; bf16x2_t b = __builtin_convertvector(v, bf16x2_t); return __builtin_bit_cast(unsigned, b); }
#define ATT_SBAR() __builtin_amdgcn_sched_barrier(0)
__device__ __forceinline__ void pv2(f32x16 (&o)[2][2], int vb, const bf16x8 (&pa)[2][4]) {
#pragma unroll
    for (int d0 = 0; d0 < 2; ++d0) { s16x4 lo[4], hi[4];
#pragma unroll
        for (int ks = 0; ks < 4; ++ks) {
            asm volatile("ds_read_b64_tr_b16 %0,%1 offset:%c2" : "=&v"(lo[ks]) : "v"(vb), "i"(d0 * 4096 + ks * 1024) : "memory");
            asm volatile("ds_read_b64_tr_b16 %0,%1 offset:%c2" : "=&v"(hi[ks]) : "v"(vb), "i"(d0 * 4096 + ks * 1024 + 512) : "memory"); }
        asm volatile("s_waitcnt lgkmcnt(0)" ::: "memory"); ATT_SBAR();
#pragma unroll
        for (int ks = 0; ks < 4; ++ks) { const bf16x8 vf = (bf16x8){lo[ks][0], lo[ks][1], lo[ks][2], lo[ks][3], hi[ks][0], hi[ks][1], hi[ks][2], hi[ks][3]};
            o[0][d0] = __builtin_amdgcn_mfma_f32_32x32x16_bf16(pa[0][ks], vf, o[0][d0], 0, 0, 0);
            o[1][d0] = __builtin_amdgcn_mfma_f32_32x32x16_bf16(pa[1][ks], vf, o[1][d0], 0, 0, 0); }
    }
}
__device__ __forceinline__ void unit(LAS unsigned char* shm, const bf16* Z, bf16* CAT, float sinkv, int qrow0, int qpos0, int krow_ctx, int krow_lat, int kh, bool latent, int wid, int lane) {
    constexpr float THR = 8.f;
    const int r32 = lane & 31, hi = lane >> 5; const int head = kh * 8 + wid;
    const unsigned lds0 = (unsigned)(uintptr_t)shm;
    LAS float* wsf = (LAS float*)(shm + LDS_WS) + wid * 64;
    bf16x8 qr[2][4];
    int jlo = 0, nband = 0;
    if (latent) { const int j = qpos0 >> 6; jlo = j - 2 < 0 ? 0 : j - 2; const int jhi = j + 2 > 63 ? 63 : j + 2; nband = jhi - jlo + 1; }
    const int NT = 4 + nband;
    const size_t koff = (size_t)lane * N_IN + OFF_K + kh * 64 + wid * 8;
    const size_t voff = (size_t)(16 * (wid & 3) + (lane >> 2)) * N_IN + OFF_V + kh * 64 + (wid >> 2) * 32 + (lane & 3) * 8;
    const unsigned kdst = lds0 + LDS_K + wid * 1024, vdst = lds0 + LDS_V + wid * 1024;
#define ATT_TROW(t) ((t) < 4 ? krow_ctx + 64 * (t) : krow_lat + 64 * (jlo + (t) - 4))
#define ATT_DMA(t, slot) do { const int tr_ = ATT_TROW(t); glds16(Z + (size_t)tr_ * N_IN + koff, (unsigned)__builtin_amdgcn_readfirstlane(kdst + (slot))); glds16(Z + (size_t)tr_ * N_IN + voff, (unsigned)__builtin_amdgcn_readfirstlane(vdst + (slot))); } while (0)
    const int vb0 = (int)(lds0 + LDS_V) + ((lane >> 4) & 1) * 32 + (lane & 3) * 8 + (4 * hi + ((lane & 15) >> 2)) * 64;
    float m[2] = {0.f, 0.f}, l[2] = {0.f, 0.f}; f32x16 o[2][2]; o[0][0] = f32x16{}; o[0][1] = f32x16{}; o[1][0] = f32x16{}; o[1][1] = f32x16{};
    f32x16 negm[2]; negm[0] = f32x16{}; negm[1] = f32x16{};
    ATT_DMA(0, 0);
#pragma unroll
    for (int x = 0; x < 2; ++x) { const bf16* Qw = Z + (size_t)(qrow0 + 32 * x + r32) * N_IN + head * 64 + hi * 8;
#pragma unroll
        for (int d0 = 0; d0 < 4; ++d0) qr[x][d0] = *(const bf16x8*)(Qw + d0 * 16); }
    asm volatile("s_waitcnt vmcnt(0)" ::: "memory");
    ATT_DMA(1, SLOTB);
    int slot = 0, slot2 = 2 * SLOTB;
#pragma unroll 1
    for (int t = 0; t < NT; ++t) {
        if (t + 1 < NT) { asm volatile("s_waitcnt vmcnt(2)\n\ts_barrier" ::: "memory"); } else { asm volatile("s_waitcnt vmcnt(0)\n\ts_barrier" ::: "memory"); }
        if (t + 2 < NT) ATT_DMA(t + 2, slot2);
        f32x16 p[2][2]; p[0][0] = negm[0]; p[0][1] = negm[0]; p[1][0] = negm[1]; p[1][1] = negm[1];
        { const LAS unsigned char* kb = shm + LDS_K + slot + hi * 1024 + r32 * 16;
#pragma unroll
          for (int d0 = 0; d0 < 4; ++d0) { const bf16x8 b0 = *(const LAS bf16x8*)(kb + d0 * 2048), b1 = *(const LAS bf16x8*)(kb + d0 * 2048 + 512);
#pragma unroll
              for (int x = 0; x < 2; ++x) { p[x][0] = __builtin_amdgcn_mfma_f32_32x32x16_bf16(b0, qr[x][d0], p[x][0], 0, 0, 0); p[x][1] = __builtin_amdgcn_mfma_f32_32x32x16_bf16(b1, qr[x][d0], p[x][1], 0, 0, 0); } } }
        bf16x8 pa[2][4];
#pragma unroll
        for (int x = 0; x < 2; ++x) {
            if (t >= 4) { const int kp0 = 64 * (jlo + t - 4), qx0 = qpos0 + 32 * x;
                if (kp0 + 63 - qx0 > 128 || qx0 + 31 - kp0 > 128) {
#pragma unroll
                    for (int r = 0; r < 16; ++r) { const int d = kp0 + crow(r, hi) - (qx0 + r32); if (d > 128 || d < -128) p[x][0][r] = -INFINITY; if (d + 32 > 128 || d + 32 < -128) p[x][1][r] = -INFINITY; } } }
            float mx = __builtin_fmaxf(__builtin_fmaxf(p[x][0][0], p[x][1][0]), __builtin_fmaxf(p[x][0][1], p[x][1][1]));
#pragma unroll
            for (int r = 2; r < 16; r += 2) mx = __builtin_fmaxf(__builtin_fmaxf(mx, __builtin_fmaxf(p[x][0][r], p[x][1][r])), __builtin_fmaxf(p[x][0][r + 1], p[x][1][r + 1]));
            { auto rr = __builtin_amdgcn_permlane32_swap(__float_as_uint(mx), __float_as_uint(mx), false, false); mx = __builtin_fmaxf(__uint_as_float(rr[0]), __uint_as_float(rr[1])); }
            if (__any(t == 0 || mx > THR)) {
                const float d = t == 0 ? mx : __builtin_fmaxf(mx, 0.f), f = t == 0 ? 0.f : __builtin_amdgcn_exp2f(-d); m[x] += d; l[x] *= f;
#pragma unroll
                for (int r = 0; r < 16; ++r) { p[x][0][r] -= d; p[x][1][r] -= d; negm[x][r] = -m[x]; }
                if (t > 0) { if (hi == 0) wsf[r32] = f;
#pragma unroll
                    for (int r = 0; r < 16; ++r) { const float g = wsf[crow(r, hi)]; o[x][0][r] *= g; o[x][1][r] *= g; } } }
            float rs = 0.f;
#pragma unroll
            for (int r = 0; r < 16; ++r) { p[x][0][r] = __builtin_amdgcn_exp2f(p[x][0][r]); p[x][1][r] = __builtin_amdgcn_exp2f(p[x][1][r]); rs += p[x][0][r] + p[x][1][r]; }
            l[x] += rs;
#pragma unroll
            for (int k = 0; k < 4; ++k) { const int h2 = k >> 1, b8 = (k & 1) * 8;
                const u32x4 w = (u32x4){cvtpk_s(p[x][h2][b8 + 0], p[x][h2][b8 + 1]), cvtpk_s(p[x][h2][b8 + 2], p[x][h2][b8 + 3]), cvtpk_s(p[x][h2][b8 + 4], p[x][h2][b8 + 5]), cvtpk_s(p[x][h2][b8 + 6], p[x][h2][b8 + 7])};
                pa[x][k] = __builtin_bit_cast(bf16x8, w); }
        }
        pv2(o, vb0 + slot, pa);
        asm volatile("s_waitcnt lgkmcnt(0)" ::: "memory");
        { const int s_ = slot; slot = slot == 2 * SLOTB ? 0 : slot + SLOTB; slot2 = s_; }
    }
#undef ATT_DMA
#undef ATT_TROW
#pragma unroll
    for (int x = 0; x < 2; ++x) { float lx = l[x];
        { auto rr = __builtin_amdgcn_permlane32_swap(__float_as_uint(lx), __float_as_uint(lx), false, false); lx = __uint_as_float(rr[0]) + __uint_as_float(rr[1]); }
        lx += __builtin_amdgcn_exp2f(sinkv * LOG2E - m[x]);
        if (hi == 0) wsf[32 + r32] = lx;
        asm volatile("s_waitcnt lgkmcnt(0)" ::: "memory");
        float rli[16];
#pragma unroll
        for (int r = 0; r < 16; ++r) rli[r] = __builtin_amdgcn_rcpf(wsf[32 + crow(r, hi)]);
        bf16* Ow = CAT + (size_t)(qrow0 + 32 * x) * DM + head * 64;
        LAS bf16* stg = (LAS bf16*)(shm + LDS_OST) + wid * 2048;
#pragma unroll
        for (int r = 0; r < 16; ++r) { const int orow = crow(r, hi);
#pragma unroll
            for (int d0 = 0; d0 < 2; ++d0) stg[orow * 64 + d0 * 32 + r32] = (bf16)f2bf(o[x][d0][r] * rli[r]); }
        asm volatile("s_waitcnt lgkmcnt(0)" ::: "memory");
#pragma unroll
        for (int i = 0; i < 4; ++i) { const int row = i * 8 + (lane >> 3), ch = lane & 7; const u32x4 v = *(const LAS u32x4*)(stg + row * 64 + ch * 8); *(u32x4*)(Ow + (size_t)row * DM + ch * 8) = v; }
        asm volatile("s_waitcnt lgkmcnt(0)" ::: "memory"); }
    asm volatile("s_waitcnt lgkmcnt(0)\n\ts_barrier" ::: "memory");
}
#undef ATT_SBAR
}
__device__ __forceinline__ void attn_phase(const Frame& F, const Args& a, int l, bool with_ctx) {
    const bf16* Z = (const bf16*)(a.ws + WS_Z); bf16* CAT = (bf16*)(a.ws + WS_CAT); const float* sink = a.in[I_SINK] + l * 16;
    const int v = (F.G % 8 == 0) ? (F.bid % 8) * (F.G / 8) + F.bid / 8 : F.bid;
    const int NU = 512 + (with_ctx ? 32 : 0);
#pragma unroll 1
    for (int ui = v; ui < NU; ui += F.G) {
        const bool lat = ui < 512; const int uc = ui - 512;
        const int b = lat ? ui >> 7 : uc >> 3, kh = lat ? (ui >> 6) & 1 : (uc >> 2) & 1, qb = lat ? ui & 63 : uc & 3;
        att::unit(F.lds + RING_OFF, Z, CAT, sink[kh * 8 + F.wave], (lat ? b * SEQ : ML + b * CTXL) + qb * 64, lat ? qb * 64 : 0, ML + b * CTXL, b * SEQ, kh, lat, F.wave, F.lane);
    }
}

typedef short bf16x8_t __attribute__((ext_vector_type(8)));
__device__ __forceinline__ void s5_tables(const Frame& F, const Args& a) {
    unsigned char* ws = a.ws; const float* AP = (const float*)(ws + WS_APOW); const float* SBR = (const float*)(ws + WS_SBBR); const float* SBI = (const float*)(ws + WS_SBBI);
    const float* cre = a.in[I_CRE]; const float* cim = a.in[I_CIM];
    bf16* KL = (bf16*)(ws + WS_KL); bf16* PT = (bf16*)(ws + WS_PT); bf16* ET = (bf16*)(ws + WS_ET);
    LAS float* L = (LAS float*)(F.lds + RING_OFF);
    constexpr int DS = 6272;
    WG_BAR();
#pragma unroll 1
    for (int lg = F.bid; lg < DEPTH * 32; lg += F.G) { const int l = lg >> 5, g = lg & 31;
        for (int i = F.tid; i < 2 * DS; i += NWAVES * 64) { const int d = i / DS, r = i % DS; const int i0 = ((l * 2 + d) * 32 + g) * 64; float v;
            if (r < 2176) v = AP[(size_t)i0 * 34 + r]; else if (r < 3200) v = SBR[(size_t)i0 * 16 + r - 2176]; else if (r < 4224) v = SBI[(size_t)i0 * 16 + r - 3200];
            else if (r < 5248) v = cre[(size_t)(i0 >> 6) * 1024 + r - 4224]; else v = cim[(size_t)(i0 >> 6) * 1024 + r - 5248];
            L[i] = v; }
        WG_BAR();
        { const int d = F.tid >> 8, k = (F.tid >> 4) & 15, h = F.tid & 15; const LAS float* D = L + d * DS; float acc[16];
#pragma unroll
          for (int hp = 0; hp < 16; ++hp) acc[hp] = 0.f;
#pragma unroll 4
          for (int p = 0; p < 64; ++p) { const float pr = D[p * 34 + 2 * k], pi = D[p * 34 + 2 * k + 1], cr = D[4224 + h * 64 + p], ci = D[5248 + h * 64 + p]; const float wr = cr * pr - ci * pi, wi = cr * pi + ci * pr;
#pragma unroll
              for (int q4 = 0; q4 < 4; ++q4) { const f32x4 br = *(const LAS f32x4*)(D + 2176 + p * 16 + 4 * q4), bi = *(const LAS f32x4*)(D + 3200 + p * 16 + 4 * q4);
#pragma unroll
                  for (int e = 0; e < 4; ++e) acc[4 * q4 + e] += wr * br[e] - wi * bi[e]; } }
          if (k == 0 && d == 1) {
#pragma unroll
              for (int hp = 0; hp < 16; ++hp) L[2 * DS + h * 16 + hp] = acc[hp]; }
          WG_BAR();
          if (k == 0 && d == 0) { const float dsk = a.in[I_SD][l * SSM_W + g * 16 + h];
#pragma unroll
              for (int hp = 0; hp < 16; ++hp) acc[hp] += L[2 * DS + h * 16 + hp] + (hp == h ? dsk : 0.f); }
          if (!(k == 0 && d == 1)) { const int li = d == 0 ? 15 + k : 15 - k; v4u w0, w1;
              w0.x = pk2(acc[0], acc[1]); w0.y = pk2(acc[2], acc[3]); w0.z = pk2(acc[4], acc[5]); w0.w = pk2(acc[6], acc[7]); w1.x = pk2(acc[8], acc[9]); w1.y = pk2(acc[10], acc[11]); w1.z = pk2(acc[12], acc[13]); w1.w = pk2(acc[14], acc[15]);
              v4u* o = (v4u*)(KL + (((size_t)lg * 31 + li) * 16 + h) * 16); o[0] = w0; o[1] = w1; } }
#pragma unroll 1
        for (int e8 = F.tid; e8 < 8192; e8 += NWAVES * 64) { unsigned pw[4], ew[4];
#pragma unroll
            for (int j = 0; j < 4; ++j) { float pv[2], ev[2];
#pragma unroll
                for (int u = 0; u < 2; ++u) { const int idx = e8 * 8 + 2 * j + u;
                    { const int kk = idx & 255, tp = kk >> 4, hp = kk & 15, s = idx >> 8, d = s >> 7, p = (s >> 1) & 63, ri = s & 1; const LAS float* D = L + d * DS; const int k = d ? tp : 15 - tp;
                      const float pr = D[p * 34 + 2 * k], pi = D[p * 34 + 2 * k + 1], br = D[2176 + p * 16 + hp], bi = D[3200 + p * 16 + hp]; pv[u] = ri ? pr * bi + pi * br : pr * br - pi * bi; }
                    { const int s = idx & 255, d = s >> 7, p = (s >> 1) & 63, ri = s & 1, th = idx >> 8, t = th >> 4, h = th & 15; const LAS float* D = L + d * DS; const int k = d ? 16 - t : t + 1;
                      const float pr = D[p * 34 + 2 * k], pi = D[p * 34 + 2 * k + 1], cr = D[4224 + h * 64 + p], ci = D[5248 + h * 64 + p]; ev[u] = ri ? -(cr * pi + ci * pr) : cr * pr - ci * pi; } }
                pw[j] = pk2(pv[0], pv[1]); ew[j] = pk2(ev[0], ev[1]); }
            *(v4u*)(PT + (size_t)lg * 65536 + e8 * 8) = (v4u){pw[0], pw[1], pw[2], pw[3]}; *(v4u*)(ET + (size_t)lg * 65536 + e8 * 8) = (v4u){ew[0], ew[1], ew[2], ew[3]}; }
        WG_BAR();
    }
}
__device__ __forceinline__ void s5_stage_u(const Frame& F, const bf16* Z, int g, int c0, int nc, LAS unsigned char* dst) {
    v4u w[8];
#pragma unroll
    for (int j = 0; j < 8; ++j) { const int p0 = F.tid + j * NWAVES * 64, p = p0 < nc * 32 ? p0 : nc * 32 - 1; const int r = p >> 1, hf = p & 1; w[j] = *(const v4u*)(Z + (size_t)(c0 * 16 + r) * N_IN + OFF_S + g * 16 + hf * 8); }
#pragma unroll
    for (int j = 0; j < 8; ++j) { const int p = F.tid + j * NWAVES * 64; if (p < nc * 32) { const int r = p >> 1, hf = p & 1; *(LAS v4u*)(dst + (r >> 4) * 528 + (r & 15) * 32 + hf * 16) = w[j]; } }
}
__device__ __forceinline__ void s5_chunk_states(const Frame& F, const Args& a, int l) {
    const bf16* Z = (const bf16*)(a.ws + WS_Z); const bf16* PT = (const bf16*)(a.ws + WS_PT); float* CS = (float*)(a.ws + WS_CS);
    const int n16 = F.lane & 15, kq = F.lane >> 4; LAS unsigned char* UL = F.lds + RING_OFF;
#pragma unroll 1
    for (int it = F.bid; it < 384; it += F.G) {
        const bool lat = it < 256; const int g = it & 31, c0 = lat ? 128 * (it >> 5) : 1024 + 16 * ((it - 256) >> 5), nct = lat ? 8 : 1; const int lg = l * 32 + g;
        s5_stage_u(F, Z, g, c0, nct * 16, UL); asm volatile("" ::: "memory");
        bf16x8_t af[2][8];
#pragma unroll
        for (int q = 0; q < 2; ++q)
#pragma unroll
            for (int ks = 0; ks < 8; ++ks) af[q][ks] = *(const bf16x8_t*)(PT + ((size_t)lg * 256 + 32 * F.wave + 16 * q + n16) * 256 + 32 * ks + 8 * kq);
        WG_BAR();
#pragma unroll 2
        for (int ct = 0; ct < nct; ++ct) { const int chunk = c0 + 16 * ct + n16; bf16x8_t bfr[8];
#pragma unroll
            for (int ks = 0; ks < 8; ++ks) bfr[ks] = *(const LAS bf16x8_t*)(UL + (16 * ct + n16) * 528 + (2 * ks + (kq >> 1)) * 32 + (kq & 1) * 16);
            f32x4 acc0 = (f32x4){0.f, 0.f, 0.f, 0.f}, acc1 = acc0;
#pragma unroll
            for (int ks = 0; ks < 8; ++ks) { acc0 = __builtin_amdgcn_mfma_f32_16x16x32_bf16(af[0][ks], bfr[ks], acc0, 0, 0, 0); acc1 = __builtin_amdgcn_mfma_f32_16x16x32_bf16(af[1][ks], bfr[ks], acc1, 0, 0, 0); }
            float* o = CS + ((size_t)chunk * 32 + g) * 256 + 32 * F.wave + 4 * kq; *(f32x4*)o = acc0; *(f32x4*)(o + 16) = acc1; }
        WG_BAR();
    }
}
__device__ __forceinline__ void s5_carries(const Frame& F, const Args& a, int l) {
    const float* CS = (const float*)(a.ws + WS_CS); unsigned* CY = (unsigned*)(a.ws + WS_CY); const float* AP = (const float*)(a.ws + WS_APOW);
    for (int ci = F.gws; ci < 256; ci += F.NGW) {
        const int dir = ci & 1, g = (ci >> 1) & 31, b = ci >> 6; const int i = ((l * 2 + dir) * 32 + g) * 64 + F.lane;
        const float ar = AP[((size_t)i * 17 + 16) * 2], ai = AP[((size_t)i * 17 + 16) * 2 + 1]; float hr = 0.f, hi = 0.f;
        const size_t lane_off = (size_t)g * 256 + dir * 128 + 2 * F.lane;
#define S5_CIDX(step) ((step) < 16 ? 1024 + 16 * b + (dir ? 15 - (step) : (step)) : 256 * b + (dir ? 271 - (step) : (step) - 16))
        f32x2 sa[34], sb[34];
#pragma unroll
        for (int j = 0; j < 34; ++j) sa[j] = *(const f32x2*)(CS + (size_t)S5_CIDX(j) * 8192 + lane_off);
#pragma unroll 1
        for (int s0 = 0; s0 < 272; s0 += 68) {
#pragma unroll
            for (int j = 0; j < 34; ++j) sb[j] = *(const f32x2*)(CS + (size_t)S5_CIDX(s0 + 34 + j) * 8192 + lane_off);
#pragma unroll
            for (int j = 0; j < 34; ++j) { CY[((size_t)S5_CIDX(s0 + j) * 8192 + lane_off) >> 1] = pk2(hr, hi); const float nr = ar * hr - ai * hi + sa[j].x, ni = ar * hi + ai * hr + sa[j].y; hr = nr; hi = ni; }
            if (s0 + 68 < 272) {
#pragma unroll
                for (int j = 0; j < 34; ++j) sa[j] = *(const f32x2*)(CS + (size_t)S5_CIDX(s0 + 68 + j) * 8192 + lane_off); }
#pragma unroll
            for (int j = 0; j < 34; ++j) { CY[((size_t)S5_CIDX(s0 + 34 + j) * 8192 + lane_off) >> 1] = pk2(hr, hi); const float nr = ar * hr - ai * hi + sb[j].x, ni = ar * hi + ai * hr + sb[j].y; hr = nr; hi = ni; }
        }
#undef S5_CIDX
    }
}
__device__ __forceinline__ void s5_outputs(const Frame& F, const Args& a, int l, bool with_ctx) {
    const bf16* Z = (const bf16*)(a.ws + WS_Z); const bf16* KL = (const bf16*)(a.ws + WS_KL); const bf16* ET = (const bf16*)(a.ws + WS_ET); const bf16* CY = (const bf16*)(a.ws + WS_CY); bf16* GS = (bf16*)(a.ws + WS_GS);
    const int n16 = F.lane & 15, kq = F.lane >> 4; const int NI = with_ctx ? 384 : 256; LAS unsigned char* UL = F.lds + RING_OFF; LAS unsigned char* CL = UL + 128 * 528;
#pragma unroll 1
    for (int it = F.bid; it < NI; it += F.G) {
        const bool lat = it < 256; const int g = it & 31, c0 = lat ? 128 * (it >> 5) : 1024 + 16 * ((it - 256) >> 5), nct = lat ? 8 : 1; const int lg = l * 32 + g;
        s5_stage_u(F, Z, g, c0, nct * 16, UL);
        { v4u w[8];
#pragma unroll
          for (int j = 0; j < 8; ++j) { const int p0 = F.tid + j * NWAVES * 64, p = p0 < nct * 16 * 32 ? p0 : nct * 16 * 32 - 1; const int c = p >> 5, pc = p & 31; w[j] = *(const v4u*)(CY + ((size_t)(c0 + c) * 32 + g) * 256 + pc * 8); }
#pragma unroll
          for (int j = 0; j < 8; ++j) { const int p = F.tid + j * NWAVES * 64; if (p < nct * 16 * 32) { const int c = p >> 5, pc = p & 31; *(LAS v4u*)(CL + c * 528 + pc * 16) = w[j]; } } }
        asm volatile("" ::: "memory");
        bf16x8_t af[2][16];
#pragma unroll
        for (int q = 0; q < 2; ++q) { const int t = 2 * F.wave + q;
#pragma unroll
            for (int ks = 0; ks < 8; ++ks) { const int tp = 2 * ks + (kq >> 1); af[q][ks] = *(const bf16x8_t*)(KL + (((size_t)lg * 31 + (t - tp + 15)) * 16 + n16) * 16 + 8 * (kq & 1)); }
#pragma unroll
            for (int ks = 0; ks < 8; ++ks) af[q][8 + ks] = *(const bf16x8_t*)(ET + ((size_t)lg * 256 + t * 16 + n16) * 256 + 32 * ks + 8 * kq); }
        WG_BAR();
#pragma unroll 1
        for (int ct = 0; ct < nct; ++ct) { const int chunk = c0 + 16 * ct + n16; bf16x8_t bfr[16];
#pragma unroll
            for (int ks = 0; ks < 8; ++ks) bfr[ks] = *(const LAS bf16x8_t*)(UL + (16 * ct + n16) * 528 + (2 * ks + (kq >> 1)) * 32 + (kq & 1) * 16);
#pragma unroll
            for (int ks = 0; ks < 8; ++ks) bfr[8 + ks] = *(const LAS bf16x8_t*)(CL + (16 * ct + n16) * 528 + ks * 64 + kq * 16);
            f32x4 acc0 = (f32x4){0.f, 0.f, 0.f, 0.f}, acc1 = acc0;
#pragma unroll
            for (int ks = 0; ks < 16; ++ks) { acc0 = __builtin_amdgcn_mfma_f32_16x16x32_bf16(af[0][ks], bfr[ks], acc0, 0, 0, 0); acc1 = __builtin_amdgcn_mfma_f32_16x16x32_bf16(af[1][ks], bfr[ks], acc1, 0, 0, 0); }
            { const size_t r0 = (size_t)(chunk * 16 + 2 * F.wave); v2u w0, w1;
              w0.x = pk2(gelu_tanh(acc0[0]), gelu_tanh(acc0[1])); w0.y = pk2(gelu_tanh(acc0[2]), gelu_tanh(acc0[3])); w1.x = pk2(gelu_tanh(acc1[0]), gelu_tanh(acc1[1])); w1.y = pk2(gelu_tanh(acc1[2]), gelu_tanh(acc1[3]));
              *(v2u*)(GS + r0 * SSM_W + g * 16 + 4 * kq) = w0; *(v2u*)(GS + (r0 + 1) * SSM_W + g * 16 + 4 * kq) = w1; }
        }
        WG_BAR();
    }
}
__device__ __forceinline__ void gmlp_phase(const Frame& F, const Args& a, int l, bool with_ctx) {
    const bf16* Z = (const bf16*)(a.ws + WS_Z); bf16* CAT = (bf16*)(a.ws + WS_CAT); const bf16* WSB = (const bf16*)(a.ws + WS_WSB) + (size_t)l * 4 * 128 * 128;
    const float* lg = a.in[I_LNG] + l * GMLP_W; const float* lb = a.in[I_LNB] + l * GMLP_W; const float* bs = a.in[I_BS] + l * 512;
    constexpr int RS = 1056; const int n16 = F.lane & 15, kq = F.lane >> 4, q4 = (F.lane & 15) >> 2, p4 = F.lane & 3;
    const unsigned lds0 = (unsigned)(uintptr_t)(F.lds + RING_OFF);
    const int NU = with_ctx ? 136 : 128;
    float lgv[8], lbv[8];
#pragma unroll
    for (int j = 0; j < 8; ++j) { lgv[j] = lg[8 * F.lane + j]; lbv[j] = lb[8 * F.lane + j]; }
#pragma unroll 1
    for (int u = F.G - 1 - F.bid; u < NU; u += F.G) {
        const int rb = u * 128;
        v4u wrow[16];
#pragma unroll
        for (int jj = 0; jj < 16; ++jj) wrow[jj] = *(const v4u*)(Z + (size_t)(rb + 16 * F.wave + jj) * N_IN + OFF_GV + 8 * F.lane);
#pragma unroll
        for (int jj = 0; jj < 16; ++jj) { const int j = 16 * F.wave + jj;
            const v4u w = wrow[jj]; float e[8];
            e[0] = gelu_tanh(bflo(w.x)); e[1] = gelu_tanh(bfhi(w.x)); e[2] = gelu_tanh(bflo(w.y)); e[3] = gelu_tanh(bfhi(w.y)); e[4] = gelu_tanh(bflo(w.z)); e[5] = gelu_tanh(bfhi(w.z)); e[6] = gelu_tanh(bflo(w.w)); e[7] = gelu_tanh(bfhi(w.w));
            float s = 0.f;
#pragma unroll
            for (int k = 0; k < 8; ++k) s += e[k];
            const float mu = wave_sum(s) * (1.f / GMLP_W); float qq = 0.f;
#pragma unroll
            for (int k = 0; k < 8; ++k) { e[k] -= mu; qq += e[k] * e[k]; }
            const float rstd = 1.f / sqrtf(wave_sum(qq) * (1.f / GMLP_W) + NORM_EPS);
#pragma unroll
            for (int k = 0; k < 8; ++k) e[k] = e[k] * rstd * lgv[k] + lbv[k];
            v4u o; o.x = pk2(e[0], e[1]); o.y = pk2(e[2], e[3]); o.z = pk2(e[4], e[5]); o.w = pk2(e[6], e[7]);
            *(LAS v4u*)(F.lds + RING_OFF + j * RS + 16 * F.lane) = o; }
        asm volatile("s_waitcnt lgkmcnt(0)\n\ts_barrier" ::: "memory");
#pragma unroll 1
        for (int g = 0; g < 4; ++g) {
            bf16x8_t af[4];
#pragma unroll
            for (int ks = 0; ks < 4; ++ks) af[ks] = *(const bf16x8_t*)(WSB + ((size_t)g * 128 + 16 * F.wave + n16) * 128 + 32 * ks + 8 * kq);
            const f32x4 bsv = *(const f32x4*)(bs + g * 128 + 16 * F.wave + 4 * kq);
            unsigned guv[8][4];
#pragma unroll
            for (int c8 = 0; c8 < 8; ++c8)
#pragma unroll
                for (int e = 0; e < 4; ++e) guv[c8][e] = (unsigned)Z[(size_t)(rb + 16 * F.wave + 4 * kq + e) * N_IN + OFF_GU + 16 * (g * 8 + c8) + n16];
#pragma unroll
            for (int c8 = 0; c8 < 8; ++c8) { const int ct = g * 8 + c8;
                const unsigned ab = lds0 + RS * (8 * kq + q4) + 32 * ct + 8 * p4;
                typedef short s16x4_t __attribute__((ext_vector_type(4))); s16x4_t t0[4], t1[4];
#pragma unroll
                for (int ks = 0; ks < 4; ++ks) { asm volatile("ds_read_b64_tr_b16 %0, %1" : "=&v"(t0[ks]) : "v"(ab + RS * 32 * ks) : "memory"); asm volatile("ds_read_b64_tr_b16 %0, %1" : "=&v"(t1[ks]) : "v"(ab + RS * (32 * ks + 4)) : "memory"); }
                asm volatile("s_waitcnt lgkmcnt(0)" ::: "memory"); __builtin_amdgcn_sched_barrier(0);
                f32x4 acc = (f32x4){0.f, 0.f, 0.f, 0.f};
#pragma unroll
                for (int ks = 0; ks < 4; ++ks) { const bf16x8_t bfr = (bf16x8_t){t0[ks][0], t0[ks][1], t0[ks][2], t0[ks][3], t1[ks][0], t1[ks][1], t1[ks][2], t1[ks][3]}; acc = __builtin_amdgcn_mfma_f32_16x16x32_bf16(af[ks], bfr, acc, 0, 0, 0); }
                const int ch = 16 * ct + n16;
#pragma unroll
                for (int e = 0; e < 4; ++e) { const size_t row = (size_t)(rb + 16 * F.wave + 4 * kq + e);
                    const float gu = __uint_as_float(guv[c8][e] << 16); CAT[row * DM + 1536 + ch] = (bf16)f2bf(gelu_tanh(gu) * (acc[e] + bsv[e])); }
            }
        }
        asm volatile("s_waitcnt lgkmcnt(0)\n\ts_barrier" ::: "memory");
    }
}


namespace pg8 {
__device__ __forceinline__ void rstd_table(const float* ssq, int pm, PG8_LAS float* rt, int tid) {
    if (tid < 256) { const f32x4* p = (const f32x4*)(ssq + (size_t)(pm * BM + tid) * 32); f32x4 s = p[0];
#pragma unroll
        for (int j = 1; j < 8; ++j) s = s + p[j];
        rt[tid] = 1.f / sqrtf(((s[0] + s[1]) + (s[2] + s[3])) * (1.f / 2048.f) + 1e-6f); }
    asm volatile("s_waitcnt lgkmcnt(0)\n\ts_barrier" ::: "memory");
}
struct EpiIn {
    static constexpr bool PERM = true, AFTER_DRAIN = false, PERM_A = false;
    bf16_t* Z; const float* rstd_; const float* shw; const PG8_LAS float* rtab;
    __device__ __forceinline__ void operator()(const f32x4 (&acc)[2][2][4][2], const Unit& u, int wr, int wc, int fr, int fq) const {
        const bool lat = u.pm < 64, ropeq = u.pn < 4, ropek = u.pn == 4; const int mrow = lat ? (u.pm >> 4) : 4;
        const int col0 = u.pn * BM + wc * 32 + 8 * fq;
        f32x4 sh[2][2];
#pragma unroll
        for (int bj = 0; bj < 2; ++bj)
#pragma unroll
            for (int n = 0; n < 2; ++n) sh[bj][n] = *(const f32x4*)(shw + (size_t)mrow * (2816 + 11264) + col0 + bj * HALF + 4 * n);
        const float C2 = 0.125f * 1.4426950408889634f;
        if (!(lat && (ropeq || ropek))) {
            const float qs = ropeq ? C2 : 1.f;
#pragma unroll
            for (int ai = 0; ai < 2; ++ai)
#pragma unroll
                for (int m = 0; m < 4; ++m) { const size_t row = (size_t)u.pm * BM + ai * HALF + wr * 64 + m * 16 + fr; const float rq = rstd_[row] * qs;
#pragma unroll
                    for (int bj = 0; bj < 2; ++bj) { const f32x4 v0 = acc[ai][bj][m][0] * rq + sh[bj][0] * qs, v1 = acc[ai][bj][m][1] * rq + sh[bj][1] * qs;
                        u32x4 w; w.x = cvt_pk_bf16(v0[0], v0[1]); w.y = cvt_pk_bf16(v0[2], v0[3]); w.z = cvt_pk_bf16(v1[0], v1[1]); w.w = cvt_pk_bf16(v1[2], v1[3]);
                        *(u32x4*)(Z + row * 2816 + col0 + bj * HALF) = w; } }
        } else {
#pragma unroll
        for (int ai = 0; ai < 2; ++ai)
#pragma unroll
            for (int m = 0; m < 4; ++m) { const int r = ai * HALF + wr * 64 + m * 16 + fr; const size_t row = (size_t)u.pm * BM + r; const float rstd = rstd_[row];
                const int t = (int)(row & 4095); const PG8_LAS float* tp = rtab + ((wc & 1) ? (t & 63) : (t >> 6)) * 36 + (wc & 1) * 16 + 8 * (fq & 1) + 4 * (fq >> 1);
                const f32x4 cc = *(const PG8_LAS f32x4*)tp, ss = *(const PG8_LAS f32x4*)(tp + 64 * 36);
#pragma unroll
                for (int bj = 0; bj < 2; ++bj) { f32x4 v0 = acc[ai][bj][m][0] * rstd + sh[bj][0], v1 = acc[ai][bj][m][1] * rstd + sh[bj][1];
                    if (ropeq || bj == 0) {
#pragma unroll
                        for (int i = 0; i < 4; ++i) { auto a = __builtin_amdgcn_permlane32_swap(__float_as_uint(v0[i]), __float_as_uint(v1[i]), false, false);
                            const float x1 = __uint_as_float(a[0]), x2 = __uint_as_float(a[1]); const float o1 = x1 * cc[i] - x2 * ss[i], o2 = x1 * ss[i] + x2 * cc[i];
                            auto b = __builtin_amdgcn_permlane32_swap(__float_as_uint(o1), __float_as_uint(o2), false, false); v0[i] = __uint_as_float(b[0]); v1[i] = __uint_as_float(b[1]); } }
                    if (ropeq) { v0 = v0 * C2; v1 = v1 * C2; }
                    u32x4 w; w.x = cvt_pk_bf16(v0[0], v0[1]); w.y = cvt_pk_bf16(v0[2], v0[3]); w.z = cvt_pk_bf16(v1[0], v1[1]); w.w = cvt_pk_bf16(v1[2], v1[3]);
                    *(u32x4*)(Z + row * 2816 + col0 + bj * HALF) = w; } }
        }
    }
};
struct EpiUpConv {
    static constexpr bool PERM = false, AFTER_DRAIN = false, PERM_A = true;
    bf16_t* ACT; const float* rstd_; const float* shw; const float* cw; const float* cb; float* EG; float* EV; PG8_LAS float* edg;
    __device__ __forceinline__ void operator()(const f32x4 (&acc)[2][2][4][2], const Unit& u, int wr, int wc, int fr, int fq) const {
        const int mrow = u.pm < 64 ? (u.pm >> 4) : 4; const int colg = u.pn * BM + wc * 32 + 4 * fq, cl = wc * 32 + 4 * fq, cg0 = u.pn * HALF + cl;
        f32x4 shg[2], shv[2], w0[2], w1[2], w2[2], bb[2];
#pragma unroll
        for (int n = 0; n < 2; ++n) { shg[n] = *(const f32x4*)(shw + (size_t)mrow * (2816 + 11264) + colg + 16 * n); shv[n] = *(const f32x4*)(shw + (size_t)mrow * (2816 + 11264) + colg + HALF + 16 * n);
            w0[n] = *(const f32x4*)(cw + cg0 + 16 * n); w1[n] = *(const f32x4*)(cw + 5632 + cg0 + 16 * n); w2[n] = *(const f32x4*)(cw + 2 * 5632 + cg0 + 16 * n); bb[n] = *(const f32x4*)(cb + cg0 + 16 * n); }
        f32x4 g[2][4][2], v[2][4][2];
#pragma unroll
        for (int ai = 0; ai < 2; ++ai) { const f32x4 rs4 = *(const f32x4*)(rstd_ + (size_t)u.pm * BM + ai * HALF + wr * 64 + 4 * fr);
#pragma unroll
            for (int m = 0; m < 4; ++m)
#pragma unroll
                for (int n = 0; n < 2; ++n) { g[ai][m][n] = acc[ai][0][m][n] * rs4[m] + shg[n]; v[ai][m][n] = acc[ai][1][m][n] * rs4[m] + shv[n]; } }
#pragma unroll
        for (int ai = 0; ai < 2; ++ai) { const int blk = 2 * ai + wr;
            if (fr == 0 && blk > 0) {
#pragma unroll
                for (int n = 0; n < 2; ++n) *(PG8_LAS f32x4*)(edg + (2 * blk - 1) * 128 + cl + 16 * n) = g[ai][0][n]; }
            if (fr == 15 && blk < 3) {
#pragma unroll
                for (int n = 0; n < 2; ++n) *(PG8_LAS f32x4*)(edg + (2 * blk) * 128 + cl + 16 * n) = g[ai][3][n]; } }
        { float* eg = EG + ((size_t)(u.pm * 44 + u.pn) * 4) * 128 + cl; float* ev = EV + ((size_t)(u.pm * 44 + u.pn) * 2) * 128 + cl;
          if (wr == 0 && fr == 0) {
#pragma unroll
              for (int n = 0; n < 2; ++n) { *(f32x4*)(eg + 16 * n) = g[0][0][n]; *(f32x4*)(eg + 128 + 16 * n) = g[0][1][n]; *(f32x4*)(ev + 16 * n) = v[0][0][n]; } }
          if (wr == 1 && fr == 15) {
#pragma unroll
              for (int n = 0; n < 2; ++n) { *(f32x4*)(eg + 2 * 128 + 16 * n) = g[1][2][n]; *(f32x4*)(eg + 3 * 128 + 16 * n) = g[1][3][n]; *(f32x4*)(ev + 128 + 16 * n) = v[1][3][n]; } } }
        asm volatile("s_waitcnt lgkmcnt(0)\n\ts_barrier" ::: "memory");
#pragma unroll
        for (int ai = 0; ai < 2; ++ai) { const int blk = 2 * ai + wr;
#pragma unroll
            for (int n = 0; n < 2; ++n) { f32x4 top = {0.f, 0.f, 0.f, 0.f}, bot = top;
                if (blk > 0) top = *(const PG8_LAS f32x4*)(edg + (2 * (blk - 1)) * 128 + cl + 16 * n);
                if (blk < 3) bot = *(const PG8_LAS f32x4*)(edg + (2 * (blk + 1) - 1) * 128 + cl + 16 * n);
                f32x4 upv, dnv;
#pragma unroll
                for (int i = 0; i < 4; ++i) { upv[i] = __int_as_float(__builtin_amdgcn_update_dpp(__float_as_int(top[i]), __float_as_int(g[ai][3][n][i]), 0x111, 0xf, 0xf, false));
                                              dnv[i] = __int_as_float(__builtin_amdgcn_update_dpp(__float_as_int(bot[i]), __float_as_int(g[ai][0][n][i]), 0x101, 0xf, 0xf, false)); }
#pragma unroll
                for (int m = 0; m < 4; ++m) { const f32x4 up = m == 0 ? upv : g[ai][m == 0 ? 0 : m - 1][n], dn = m == 3 ? dnv : g[ai][m == 3 ? 3 : m + 1][n]; f32x4 o;
                    const f32x4 pre = __builtin_elementwise_fma(w0[n], up, __builtin_elementwise_fma(w1[n], g[ai][m][n], __builtin_elementwise_fma(w2[n], dn, bb[n])));
                    const f32x4 ea = pre * -1.4426950408889634f, pvv = pre * v[ai][m][n]; f32x4 den;
#pragma unroll
                    for (int i = 0; i < 4; ++i) den[i] = __builtin_amdgcn_exp2f(ea[i]);
                    den = den + 1.f;
#pragma unroll
                    for (int i = 0; i < 4; ++i) den[i] = __builtin_amdgcn_rcpf(den[i]);
                    o = pvv * den;
                    typedef unsigned u32x2_t __attribute__((ext_vector_type(2))); u32x2_t w; w.x = cvt_pk_bf16(o[0], o[1]); w.y = cvt_pk_bf16(o[2], o[3]);
                    *(u32x2_t*)(ACT + (size_t)(u.pm * BM + ai * HALF + wr * 64 + 4 * fr + m) * 5632 + cg0 + 16 * n) = w; } } }
    }
};
struct EpiRes {
    static constexpr bool PERM = false, AFTER_DRAIN = false, PERM_A = false;
    float* X; const float* Xr; const float* Xrc; const float* gate; const float* gsn; bf16_t* An; float* ssq;
    __device__ __forceinline__ void operator()(const f32x4 (&acc)[2][2][4][2], const Unit& u, int wr, int wc, int fr, int fq) const {
        const int row0 = u.pm * BM + wr * 64 + fr, col0 = u.pn * BM + wc * 32 + 4 * fq; const int mrow = u.pm < 64 ? (u.pm >> 4) : 4;
        f32x4 gv[2][2], sv[2][2];
#pragma unroll
        for (int bj = 0; bj < 2; ++bj)
#pragma unroll
            for (int n = 0; n < 2; ++n) { gv[bj][n] = *(const f32x4*)(gate + (size_t)mrow * (6 * 2048) + col0 + bj * HALF + n * 16); sv[bj][n] = gsn ? *(const f32x4*)(gsn + (size_t)mrow * 2048 + col0 + bj * HALF + n * 16) : (f32x4){0.f, 0.f, 0.f, 0.f}; }
#pragma unroll
        for (int ai = 0; ai < 2; ++ai)
#pragma unroll
            for (int mp = 0; mp < 2; ++mp) { f32x4 xin[2][2][2];
#pragma unroll
                for (int mm = 0; mm < 2; ++mm) { const size_t row = (size_t)(row0 + ai * HALF + (2 * mp + mm) * 16); const float* rowr = (u.pm < 64 ? Xr : Xrc) + row * 2048 + col0;
#pragma unroll
                    for (int bj = 0; bj < 2; ++bj)
#pragma unroll
                        for (int n = 0; n < 2; ++n) xin[mm][bj][n] = *(const f32x4*)(rowr + bj * HALF + n * 16); }
#pragma unroll
                for (int mm = 0; mm < 2; ++mm) { const int m = 2 * mp + mm; const size_t row = (size_t)(row0 + ai * HALF + m * 16); float* rowp = X + row * 2048 + col0; float q = 0.f;
#pragma unroll
                    for (int bj = 0; bj < 2; ++bj)
#pragma unroll
                        for (int n = 0; n < 2; ++n) { f32x4* p = (f32x4*)(rowp + bj * HALF + n * 16); const f32x4 x = xin[mm][bj][n] + gv[bj][n] * acc[ai][bj][m][n]; *p = x; q += (x[0] * x[0] + x[1] * x[1]) + (x[2] * x[2] + x[3] * x[3]);
                            if (gsn) { const f32x4 y = x * sv[bj][n]; typedef unsigned u32x2_t __attribute__((ext_vector_type(2))); u32x2_t w; w.x = cvt_pk_bf16(y[0], y[1]); w.y = cvt_pk_bf16(y[2], y[3]); *(u32x2_t*)(An + row * 2048 + col0 + bj * HALF + n * 16) = w; } }
                    if (gsn) { { auto r_ = __builtin_amdgcn_permlane16_swap(__float_as_uint(q), __float_as_uint(q), false, false); q = __uint_as_float(r_[0]) + __uint_as_float(r_[1]); }
                                { auto r_ = __builtin_amdgcn_permlane32_swap(__float_as_uint(q), __float_as_uint(q), false, false); q = __uint_as_float(r_[0]) + __uint_as_float(r_[1]); }
                                if (fq == 0) ssq[row * 32 + u.pn * 4 + wc] = q; } } }
    }
};
struct PieceOrder {
    int c0, G, np, nks, klen_b, uneven;
    __device__ __forceinline__ bool next(int i, Unit& u) const { const int c = c0 + i * G; if (c >= np) return false; const int ks = c % nks, t = c / nks; u.pn = t & 7; u.pm = 64 + (t >> 3); u.aux = ks;
        if (uneven) { u.kb = (11 * ks - (ks & 1)) * 128; u.nt = 10 + 2 * (ks & 1); } else { u.kb = ks * klen_b; u.nt = 0; } return true; }
    __device__ __forceinline__ void a_ready(const Unit&) const {}
    __device__ __forceinline__ void done(const Unit&) const {}
};
struct EpiSlab {
    static constexpr bool PERM = false, AFTER_DRAIN = false, PERM_A = false;
    float* S;
    __device__ __forceinline__ void operator()(const f32x4 (&acc)[2][2][4][2], const Unit& u, int wr, int wc, int fr, int fq) const {
        float* base = S + ((size_t)u.aux * 1024 + (size_t)(u.pm - 64) * BM + wr * 64 + fr) * 2048 + u.pn * BM + wc * 32 + 4 * fq;
#pragma unroll
        for (int ai = 0; ai < 2; ++ai)
#pragma unroll
            for (int m = 0; m < 4; ++m)
#pragma unroll
                for (int bj = 0; bj < 2; ++bj)
#pragma unroll
                    for (int n = 0; n < 2; ++n) *(f32x4*)(base + (size_t)(ai * HALF + m * 16) * 2048 + bj * HALF + n * 16) = acc[ai][bj][m][n];
    }
};
struct EpiNone { static constexpr bool PERM = false, AFTER_DRAIN = false, PERM_A = false; float* sink;
    __device__ __forceinline__ void operator()(const f32x4 (&acc)[2][2][4][2], const Unit& u, int wr, int wc, int fr, int fq) const { f32x4 s = acc[0][0][0][0];
#pragma unroll
        for (int a = 0; a < 2; ++a)
#pragma unroll
            for (int b = 0; b < 2; ++b)
#pragma unroll
                for (int m = 0; m < 4; ++m)
#pragma unroll
                    for (int n = 0; n < 2; ++n) s = s + acc[a][b][m][n];
        if (s[0] + s[1] + s[2] + s[3] == 1.2345e-33f) sink[0] = 1.f; } };
struct EpiGlu {
    static constexpr bool PERM = true, AFTER_DRAIN = false, PERM_A = false;
    const bf16_t* Gs; const float* bias; bf16_t* O; int ldo, ooff;
    __device__ __forceinline__ void operator()(const f32x4 (&acc)[2][2][4][2], const Unit& u, int wr, int wc, int fr, int fq) const {
        const int row0 = u.pm * BM + wr * 64 + fr, col0 = u.pn * BM + wc * 32 + 8 * fq;
        f32x4 bs[2][2];
#pragma unroll
        for (int bj = 0; bj < 2; ++bj) { bs[bj][0] = *(const f32x4*)(bias + col0 + bj * HALF); bs[bj][1] = *(const f32x4*)(bias + col0 + bj * HALF + 4); }
#pragma unroll
        for (int ai = 0; ai < 2; ++ai) { u32x4 gw[4][2];
#pragma unroll
            for (int m = 0; m < 4; ++m)
#pragma unroll
                for (int bj = 0; bj < 2; ++bj) gw[m][bj] = *(const u32x4*)(Gs + (size_t)(row0 + ai * HALF + m * 16) * 512 + col0 + bj * HALF);
#pragma unroll
            for (int m = 0; m < 4; ++m) { const size_t r = (size_t)(row0 + ai * HALF + m * 16);
#pragma unroll
                for (int bj = 0; bj < 2; ++bj) { const int c = col0 + bj * HALF; const f32x4 v0 = acc[ai][bj][m][0] + bs[bj][0], v1 = acc[ai][bj][m][1] + bs[bj][1]; const u32x4 g = gw[m][bj];
                    u32x4 w;
                    w.x = cvt_pk_bf16(__uint_as_float(g.x << 16) * __builtin_amdgcn_rcpf(1.f + __builtin_amdgcn_exp2f(v0[0] * -1.4426950408889634f)), __uint_as_float(g.x & 0xffff0000u) * __builtin_amdgcn_rcpf(1.f + __builtin_amdgcn_exp2f(v0[1] * -1.4426950408889634f)));
                    w.y = cvt_pk_bf16(__uint_as_float(g.y << 16) * __builtin_amdgcn_rcpf(1.f + __builtin_amdgcn_exp2f(v0[2] * -1.4426950408889634f)), __uint_as_float(g.y & 0xffff0000u) * __builtin_amdgcn_rcpf(1.f + __builtin_amdgcn_exp2f(v0[3] * -1.4426950408889634f)));
                    w.z = cvt_pk_bf16(__uint_as_float(g.z << 16) * __builtin_amdgcn_rcpf(1.f + __builtin_amdgcn_exp2f(v1[0] * -1.4426950408889634f)), __uint_as_float(g.z & 0xffff0000u) * __builtin_amdgcn_rcpf(1.f + __builtin_amdgcn_exp2f(v1[1] * -1.4426950408889634f)));
                    w.w = cvt_pk_bf16(__uint_as_float(g.w << 16) * __builtin_amdgcn_rcpf(1.f + __builtin_amdgcn_exp2f(v1[2] * -1.4426950408889634f)), __uint_as_float(g.w & 0xffff0000u) * __builtin_amdgcn_rcpf(1.f + __builtin_amdgcn_exp2f(v1[3] * -1.4426950408889634f)));
                    *(u32x4*)(O + r * ldo + ooff + c) = w; } } }
    }
};
}

constexpr int NP0 = 3, NPL = 11, NPH = NP0 + NPL * DEPTH + 1;
#ifndef MK_N_LAUNCHES
#define MK_N_LAUNCHES 1
#endif
__global__ void __launch_bounds__(NWAVES * 64, 2) mk_fwd(Args args) {
    extern __shared__ __attribute__((aligned(16))) unsigned char lds[];
    Frame F;
    F.lds = (LAS unsigned char*)lds; const int wave0 = __builtin_amdgcn_readfirstlane((int)threadIdx.x >> 6);
    F.tid = threadIdx.x; F.lane = F.tid & 63; F.wave = wave0; F.G = gridDim.x; F.bid = blockIdx.x; F.gw = 0; F.NGW = 0; F.gws = 0; F.gt = 0; F.NGT = 0;
    volatile LAS unsigned* MISC = (volatile LAS unsigned*)(F.lds + MISC_OFF);
    for (int u = F.tid; u < (LDS_BYTES - LDSCTL_OFF) / 4; u += NWAVES * 64) ((LAS unsigned*)(F.lds + LDSCTL_OFF))[u] = 0u;
    __syncthreads();
    const int lo = args.ph_lo, hi = args.ph_hi;
    unsigned* barw = (unsigned*)(args.ws + WS_CTL) + CW_BAR;
    XcdBarrier bar; bar.bar = barw; bar.x = 0; bar.st = nullptr;
    if (hi - lo > 1) bar = xcd_barrier_post(barw, MISC + 8);
#define IN(k) (lo <= (k) && (k) < hi)
#define FRESH() do { int w_ = wave0, b_ = (int)blockIdx.x, g_ = (int)gridDim.x, t_; asm volatile("" : "+s"(w_), "+s"(b_), "+s"(g_)); asm volatile("v_mbcnt_lo_u32_b32 %0, -1, 0\n\tv_mbcnt_hi_u32_b32 %0, -1, %0" : "=v"(t_)); t_ += w_ * 64; \
    F.wave = w_; F.bid = b_; F.G = g_; F.tid = t_; F.lane = t_ & 63; F.gw = b_ * NWAVES + w_; F.NGW = g_ * NWAVES; F.gws = w_ * g_ + b_; F.gt = b_ * (NWAVES * 64) + t_; F.NGT = g_ * NWAVES * 64; } while (0)
#define SEAM(k) do { if ((k) + 1 < hi) xcd_barrier(bar); } while (0)
#ifndef REP_MASK
#define REP_MASK 0
#endif
#define REP(kind) for (int rep_##kind = 0; rep_##kind < ((REP_MASK >> (kind)) & 1) + 1; ++rep_##kind)
#define PB() Args pa = args; { size_t z_ = 0; asm volatile("" : "+s"(z_)); pa.ws = args.ws + z_; } unsigned char* const ws = pa.ws
    if (IN(0)) REP(8) { PB(); FRESH(); p0a(F, pa); FRESH(); p0a_conv(F, pa); SEAM(0); }
    if (IN(1)) REP(9) { PB(); FRESH(); REP(10) { p0b_conv(F, pa); FRESH(); p0b(F, pa); FRESH(); } REP(11) { s5_tables(F, pa); } SEAM(1); }
    if (IN(2)) REP(12) { PB(); FRESH(); p0c(F, pa); SEAM(2); }
#pragma unroll 1
    for (int l = 0; l < DEPTH; ++l) {
        const int pb = NP0 + NPL * l; const bool last = l == DEPTH - 1;
        if (IN(pb + 0)) REP(1) { PB(); FRESH();
            pg8::Gemm g{(const bf16*)(ws + WS_A), w_in_t(ws, l), MA, N_IN, DM, DM}; pg8::StaticOrder S; S.init(MA, N_IN, F.G, F.bid);
            { const float* RC = (const float*)(ws + WS_ROPE); LAS float* tab = (LAS float*)(F.lds + ROPE_OFF);
              for (int i = F.tid; i < 2 * 64 * 32; i += NWAVES * 64) { const int cs = i >> 11, p = (i >> 5) & 63, j = i & 31; tab[cs * 64 * ROPE_STRIDE + p * ROPE_STRIDE + j] = RC[cs * SEQ * 32 + (j < 16 ? p * 64 : p) * 32 + j]; }
              WG_BAR(); }
            pg8::EpiIn E{(bf16*)(ws + WS_Z), (const float*)(ws + WS_RSTD), (const float*)(ws + WS_SHW) + (size_t)l * 5 * NSH, (const LAS float*)(F.lds + ROPE_OFF)};
            pg8::gemm_phase<pg8::EpiIn, pg8::StaticOrder, true, true>(F.lds + RING_OFF, g, S, E, F.wave);
            SEAM(pb + 0); }
        if (IN(pb + 1)) REP(2) { PB(); FRESH(); s5_chunk_states(F, pa, l); attn_phase(F, pa, l, !last); SEAM(pb + 1); }
        if (IN(pb + 2)) REP(3) { PB(); FRESH(); s5_carries(F, pa, l); gmlp_phase(F, pa, l, !last); SEAM(pb + 2); }
        if (IN(pb + 3)) REP(4) { PB(); FRESH(); s5_outputs(F, pa, l, !last); SEAM(pb + 3); }
        if (IN(pb + 4)) REP(5) { PB(); FRESH();
            pg8::Gemm g{(const bf16*)(ws + WS_GS), w_glu_t(ws, l), MA, SSM_W, SSM_W, SSM_W}; pg8::StaticOrder S; S.init(MA, SSM_W, F.G, F.bid);
            pg8::EpiGlu E{(const bf16*)(ws + WS_GS), pa.in[I_BGLU] + l * SSM_W, (bf16*)(ws + WS_CAT), DM, 1024};
            pg8::gemm_phase<pg8::EpiGlu, pg8::StaticOrder, true, true>(F.lds + RING_OFF, g, S, E, F.wave);
            SEAM(pb + 4); }
        if (IN(pb + 5)) { PB(); FRESH();
            { pg8::Gemm g{(const bf16*)(ws + WS_CAT), w_out_t(ws, l), ML, DM, DM, DM}; pg8::StaticOrder S; S.init(ML, DM, F.G, F.bid);
              pg8::EpiRes E{(float*)(ws + WS_XS), l == 0 ? pa.in[I_X] : (const float*)(ws + WS_XS), (const float*)(ws + WS_XS), (const float*)(ws + WS_MOD) + (size_t)l * 5 * NMOD + 2 * DM, (const float*)(ws + WS_GSV) + (size_t)(l * 2 + 1) * 5 * DM, (bf16*)(ws + WS_A), (float*)(ws + WS_SSQ) + (size_t)MA * 32};
              pg8::gemm_phase<pg8::EpiRes, pg8::StaticOrder, true, true>(F.lds + RING_OFF, g, S, E, F.wave); }
            if (!last) { FRESH();
              pg8::Gemm g{(const bf16*)(ws + WS_CAT), w_out_t(ws, l), MA, DM, 256, DM}; pg8::PieceOrder S{F.bid, F.G, 256, 8, 512, 0};
              pg8::EpiSlab E{(float*)(ws + WS_SLAB)};
              pg8::gemm_phase<pg8::EpiSlab, pg8::PieceOrder, true, true>(F.lds + RING_OFF, g, S, E, F.wave); }
            SEAM(pb + 5); }
        if (IN(pb + 6)) { PB(); FRESH(); lat_rstd(F, pa, 0); if (!last) ctx_reduce(F, pa, l, 0); SEAM(pb + 6); }
        if (IN(pb + 7)) REP(6) { PB(); FRESH();
            pg8::Gemm g{(const bf16*)(ws + WS_A), w_up_t(ws, l), MA, NUP, DM, DM}; pg8::StaticOrder S; S.init(last ? ML : MA, NUP, F.G, F.bid);
            pg8::EpiUpConv E{(bf16*)(ws + WS_ACT), (const float*)(ws + WS_RSTD) + MA, (const float*)(ws + WS_SHW) + (size_t)l * 5 * NSH + N_IN, pa.in[I_CW] + (size_t)l * 3 * DFF, pa.in[I_CB] + (size_t)l * DFF,
                                (float*)(ws + WS_EG), (float*)(ws + WS_EV), (LAS float*)(F.lds + EDG_OFF)};
            pg8::gemm_phase<pg8::EpiUpConv, pg8::StaticOrder, true, true>(F.lds + RING_OFF, g, S, E, F.wave);
            SEAM(pb + 7); }
        if (IN(pb + 7) && ((REP_MASK >> 13) & 1)) { PB(); FRESH();
            pg8::Gemm g{(const bf16*)(ws + WS_A), w_up_t(ws, l), MA, NUP, DM, DM}; pg8::StaticOrder S; S.init(MA, NUP, F.G, F.bid);
            pg8::EpiNone E{(float*)(ws + WS_EG)};
            pg8::gemm_phase<pg8::EpiNone, pg8::StaticOrder, true, true>(F.lds + RING_OFF, g, S, E, F.wave);
            xcd_barrier(bar); }
        if (IN(pb + 8)) REP(7) { PB(); FRESH(); conv_fixup(F, pa, l); SEAM(pb + 8); }
        if (IN(pb + 9)) { PB(); FRESH();
            { pg8::Gemm g{(const bf16*)(ws + WS_ACT), w_dn_t(ws, l), ML, DM, DFF, DFF}; pg8::StaticOrder S; S.init(ML, DM, F.G, F.bid);
              pg8::EpiRes E{(float*)(ws + WS_XS), (const float*)(ws + WS_XS), (const float*)(ws + WS_XS), (const float*)(ws + WS_MOD) + (size_t)l * 5 * NMOD + 5 * DM, last ? nullptr : (const float*)(ws + WS_GSV) + (size_t)((l + 1) * 2) * 5 * DM, (bf16*)(ws + WS_A), (float*)(ws + WS_SSQ)};
              pg8::gemm_phase<pg8::EpiRes, pg8::StaticOrder, true, true>(F.lds + RING_OFF, g, S, E, F.wave); }
            if (!last) { FRESH();
              pg8::Gemm g{(const bf16*)(ws + WS_ACT), w_dn_t(ws, l), MA, DM, 640, DFF}; pg8::PieceOrder S{F.bid, F.G, 256, 8, 0, 1};
              pg8::EpiSlab E{(float*)(ws + WS_SLAB)};
              pg8::gemm_phase<pg8::EpiSlab, pg8::PieceOrder, true, true>(F.lds + RING_OFF, g, S, E, F.wave); }
            SEAM(pb + 9); }
        if (IN(pb + 9) && ((REP_MASK >> 14) & 1)) { PB(); FRESH();
            pg8::Gemm g{(const bf16*)(ws + WS_ACT), w_dn_t(ws, l), ML, DM, DFF, DFF}; pg8::StaticOrder S; S.init(ML, DM, F.G, F.bid);
            pg8::EpiNone E{(float*)(ws + WS_EG)};
            pg8::gemm_phase<pg8::EpiNone, pg8::StaticOrder, true, true>(F.lds + RING_OFF, g, S, E, F.wave);
            xcd_barrier(bar); }
        if (IN(pb + 10) && !last) { PB(); FRESH(); lat_rstd(F, pa, 1); ctx_reduce(F, pa, l, 1); SEAM(pb + 10); }
    }
    if (IN(NPH - 1)) { PB(); FRESH(); final_norm(F, pa); }
#undef IN
#undef SEAM
}

extern "C" void kernel_launch(void* const* d_in, const int* in_sizes, int n_in, void* d_out, int out_size, void* d_ws, size_t ws_size, hipStream_t stream) {
    static int grid = 0;
    if (grid == 0) {
        if (n_in != N_INPUTS || in_sizes[0] != ML * DM || out_size != ML * DM || ws_size < WS_END2) {
            fprintf(stderr, "kernel_launch: unexpected shapes (n_in %d, in0 %d, out %d, ws %zu need %zu); nothing launched\n", n_in, n_in > 0 ? in_sizes[0] : -1, out_size, ws_size, (size_t)WS_END2); grid = -1; return; }
        int dev = 0, cus = 0, per_cu = 0;
        if (hipGetDevice(&dev) != hipSuccess || hipDeviceGetAttribute(&cus, hipDeviceAttributeMultiprocessorCount, dev) != hipSuccess) { fprintf(stderr, "kernel_launch: device query failed\n"); grid = -1; return; }
        if (hipFuncSetAttribute((const void*)mk_fwd, hipFuncAttributeMaxDynamicSharedMemorySize, LDS_BYTES) != hipSuccess) { fprintf(stderr, "kernel_launch: hipFuncSetAttribute failed\n"); grid = -1; return; }
        if (hipOccupancyMaxActiveBlocksPerMultiprocessor(&per_cu, (const void*)mk_fwd, NWAVES * 64, LDS_BYTES) != hipSuccess || per_cu < 1) { fprintf(stderr, "kernel_launch: occupancy query says %d blocks per CU\n", per_cu); }
        (void)hipGetLastError();
        grid = cus;
    }
    if (grid < 0) return;
    if (hipMemsetAsync((char*)d_ws + WS_CTL, 0, CTL_ZERO_BYTES, stream) != hipSuccess) { fprintf(stderr, "kernel_launch: memset failed\n"); return; }
    Args a{};
    for (int i = 0; i < N_INPUTS; ++i) a.in[i] = (const float*)d_in[i];
    a.out = (float*)d_out; a.ws = (unsigned char*)d_ws;
    if (MK_N_LAUNCHES == 1) { a.ph_lo = 0; a.ph_hi = NPH; hipLaunchKernelGGL(mk_fwd, dim3(grid), dim3(NWAVES * 64), LDS_BYTES, stream, a); }
    else { for (int p = 0; p < NPH; ++p) { a.ph_lo = p; a.ph_hi = p + 1; hipLaunchKernelGGL(mk_fwd, dim3(grid), dim3(NWAVES * 64), LDS_BYTES, stream, a); } }
    const hipError_t le = hipPeekAtLastError();
    if (le != hipSuccess) fprintf(stderr, "kernel_launch: launch failed: %s\n", hipGetErrorName(le));
}
```

```cpp
#include <hip/hip_runtime.h>
#include <cstdio>
#include <cstdint>
namespace pg8 {
#define PG8_LAS __attribute__((address_space(3)))
typedef unsigned short bf16_t;
typedef short bf16x8 __attribute__((ext_vector_type(8)));
typedef float f32x4 __attribute__((ext_vector_type(4)));
typedef unsigned u32x4 __attribute__((ext_vector_type(4)));
constexpr int BM = 256, BK = 64, HALF = 128, HTB = HALF * BK * 2  , STAGE_BYTES = 8 * HTB, NXCD = 8, WGM = 4;

__host__ __device__ __forceinline__ int lds_byte(int r, int c) { const int st = (r >> 4) * 2 + (c >> 5), rr = r & 15, cc = c & 31, ob = rr * 64 + cc * 2; return st * 1024 + (ob ^ (((ob >> 9) & 1) << 5)); }
__host__ __device__ __forceinline__ void stage_rc(int b, int& R, int& C) { const int st = b / 1024, sb = b % 1024, swz = sb ^ (((sb >> 9) & 1) << 5); R = (st >> 1) * 16 + swz / 64; C = (st & 1) * 32 + (swz % 64) / 2; }
__host__ __device__ __forceinline__ int perm32(int rho) { const int n = rho >> 4, i = rho & 15; return 8 * (i >> 2) + 4 * n + (i & 3); }

struct Unit { int pm, pn, kb, nt, aux; };
struct Gemm { const bf16_t* A; const bf16_t* Bt; int M, N, K, ld; };

struct StaticOrder {
    int nM, nN, nwg, G, c;
    __host__ __device__ void init(int M, int N, int G_, int c_) { nM = M / BM; nN = N / BM; nwg = nM * nN; G = G_; c = c_; }
    __host__ __device__ bool next(int i, Unit& u) const {
        const long L = (long)i * G + c; if (L >= nwg) return false;
        int wgid = (int)L; { const int q = nwg / NXCD, r = nwg % NXCD, xcd = wgid % NXCD, off = wgid / NXCD; wgid = (xcd < r ? xcd * (q + 1) : r * (q + 1) + (xcd - r) * q) + off; }
        const int nig = WGM * nN, gid = wgid / nig, fm = gid * WGM, gsz = (nM - fm) < WGM ? (nM - fm) : WGM;
        u.pm = fm + ((wgid % nig) % gsz); u.pn = (wgid % nig) / gsz; u.kb = 0; u.nt = 0; u.aux = 0; return true;
    }
    __device__ __forceinline__ void a_ready(const Unit&) const {}
    __device__ __forceinline__ void done(const Unit&) const {}
};

__device__ __forceinline__ unsigned cvt_pk_bf16(float lo, float hi) { unsigned r; asm volatile("v_cvt_pk_bf16_f32 %0, %1, %2" : "=v"(r) : "v"(lo), "v"(hi)); return r; }
typedef float f32x2 __attribute__((ext_vector_type(2)));
template <int ACT  > struct EpiBf16 {
    static constexpr bool PERM = true, AFTER_DRAIN = false, PERM_A = false; static_assert(ACT == 0 || ACT == 1, "EpiBf16: ACT is 0 (none) or 1 (gelu_pk)");
    bf16_t* O; int ldc; const float* bias; int split_cols; size_t split_stride; float scale0;
    __device__ __forceinline__ void operator()(const f32x4 (&acc)[2][2][4][2], const Unit& u, int wr, int wc, int fr, int fq) const {
        const int row0 = u.pm * BM + wr * 64 + fr; int colt = u.pn * BM; bf16_t* base = O;
        float sc = 1.f; if (split_cols) { const int t = colt / split_cols; base += (size_t)t * split_stride; colt -= t * split_cols; if (t == 0) sc = scale0; }
        const int col0 = colt + wc * 32 + 8 * fq, bcol0 = u.pn * BM + wc * 32 + 8 * fq;
        f32x4 bv[2][2];
#pragma unroll
        for (int bj = 0; bj < 2; ++bj)
#pragma unroll
            for (int n = 0; n < 2; ++n) bv[bj][n] = bias ? *(const f32x4*)(bias + bcol0 + bj * HALF + 4 * n) : (f32x4){0.f, 0.f, 0.f, 0.f};
#pragma unroll
        for (int ai = 0; ai < 2; ++ai)
#pragma unroll
            for (int m = 0; m < 4; ++m) { bf16_t* rowp = base + (size_t)(row0 + ai * HALF + m * 16) * ldc + col0;
#pragma unroll
                for (int bj = 0; bj < 2; ++bj) { f32x4 v0 = acc[ai][bj][m][0] + bv[bj][0], v1 = acc[ai][bj][m][1] + bv[bj][1];
                                        v0 = v0 * sc; v1 = v1 * sc; u32x4 w; w.x = cvt_pk_bf16(v0[0], v0[1]); w.y = cvt_pk_bf16(v0[2], v0[3]); w.z = cvt_pk_bf16(v1[0], v1[1]); w.w = cvt_pk_bf16(v1[2], v1[3]);
                    *(u32x4*)(rowp + bj * HALF) = w; } }
    }
};
template <class Epi, class Sched, bool ALIGN_EPI = false, bool SP2 = false>
__device__ __forceinline__ void gemm_phase(PG8_LAS unsigned char* lds, const Gemm g, const Sched& S, const Epi& E, const int wave_id) {
    int tid_; asm volatile("v_mbcnt_lo_u32_b32 %0, -1, 0\n\tv_mbcnt_hi_u32_b32 %0, -1, %0" : "=v"(tid_)); tid_ += wave_id * 64;
    const int tid = tid_, wid = __builtin_amdgcn_readfirstlane(tid >> 6), lane = tid & 63, wr = wid >> 2, wc = wid & 3, fr = lane & 15, fq = lane >> 4;
    const int K = g.ld, nt0 = g.K / BK;
    unsigned voffA[2], voffB[2];
#pragma unroll
    for (int i = 0; i < 2; ++i) { int R, C; stage_rc(tid * 16 + i * 8192, R, C); const int Rb = Epi::PERM ? ((R & ~31) + perm32(R & 31)) : R;
        const int Ra = Epi::PERM_A ? ((R & ~63) + 4 * (R & 15) + ((R >> 4) & 3)) : R;
        voffA[i] = (unsigned)(Ra * K + C) * 2u; voffB[i] = (unsigned)(Rb * K + C) * 2u; }
    const size_t kstep = (size_t)(BK * 2);
    const size_t hstep = (size_t)HALF * K * 2;
    const size_t tstep = 2 * hstep;
    const unsigned ldsw = (unsigned)wid * 1024u;
    const int aoff = lds_byte(wr * 64 + fr, fq * 8), boff = lds_byte(wc * 32 + fr, fq * 8);
#define PG8_SA(b, h) (((b) * 2 + (h)) * HTB)
#define PG8_SB(b, h) ((4 + (b) * 2 + (h)) * HTB)
#define PG8_STAGE(bufoff, gbase, voff) do { _Pragma("unroll") for (int _i = 0; _i < 2; ++_i) \
        __builtin_amdgcn_global_load_lds((const unsigned*)((const char*)(gbase) + (voff)[_i]), (PG8_LAS unsigned*)(lds + (bufoff) + ldsw + _i * 8192), 16, 0, 0); } while (0)
#define PG8_LDA(dst, b, h) do { _Pragma("unroll") for (int m = 0; m < 4; ++m) _Pragma("unroll") for (int k = 0; k < 2; ++k) dst[m][k] = *(const PG8_LAS bf16x8*)(lds + PG8_SA(b, h) + aoff + m * 2048 + k * 1024); } while (0)
#define PG8_LDB(dst, b, h) do { _Pragma("unroll") for (int n = 0; n < 2; ++n) _Pragma("unroll") for (int k = 0; k < 2; ++k) dst[n][k] = *(const PG8_LAS bf16x8*)(lds + PG8_SB(b, h) + boff + n * 2048 + k * 1024); } while (0)
#define PG8_MMA(ai, bj, At, Bt) do { __builtin_amdgcn_s_setprio(1); _Pragma("unroll") for (int m = 0; m < 4; ++m) _Pragma("unroll") for (int n = 0; n < 2; ++n) _Pragma("unroll") for (int k = 0; k < 2; ++k) \
        acc[ai][bj][m][n] = __builtin_amdgcn_mfma_f32_16x16x32_bf16(Bt[n][k], At[m][k], acc[ai][bj][m][n], 0, 0, 0); __builtin_amdgcn_s_setprio(0); } while (0)
#define PG8_WAIT_V(n) asm volatile("s_waitcnt vmcnt(" #n ")" ::: "memory")
#define PG8_WAIT_L(n) asm volatile("s_waitcnt lgkmcnt(" #n ")" ::: "memory")
#define PG8_BAR __builtin_amdgcn_s_barrier()
#define PG8_SCHED __builtin_amdgcn_sched_barrier(0)
    Unit cur, nxt; int ui = 0;
    if (!S.next(0, cur)) return;
    f32x4 acc[2][2][4][2];
#pragma unroll
    for (int a = 0; a < 2; ++a)
#pragma unroll
        for (int b = 0; b < 2; ++b)
#pragma unroll
            for (int m = 0; m < 4; ++m)
#pragma unroll
                for (int n = 0; n < 2; ++n) acc[a][b][m][n] = (f32x4){0.f, 0.f, 0.f, 0.f};
    bf16x8 At[4][2], B0[2][2], B1[2][2];
    const char* cA = (const char*)g.A + (size_t)cur.pm * tstep + cur.kb; const char* cB = (const char*)g.Bt + (size_t)cur.pn * tstep + cur.kb;
    S.a_ready(cur);
    if constexpr (SP2) {
        PG8_STAGE(PG8_SB(0, 0), cB, voffB); PG8_STAGE(PG8_SB(0, 1), cB + hstep, voffB); PG8_STAGE(PG8_SA(0, 0), cA, voffA); PG8_STAGE(PG8_SA(0, 1), cA + hstep, voffA);
        if (wr == 1) PG8_BAR;
        PG8_WAIT_V(2); PG8_BAR;
        PG8_STAGE(PG8_SB(1, 0), cB + kstep, voffB); PG8_STAGE(PG8_SA(1, 0), cA + kstep, voffA); PG8_STAGE(PG8_SB(1, 1), cB + hstep + kstep, voffB);
        PG8_WAIT_V(6); PG8_BAR;
    } else {
        PG8_STAGE(PG8_SB(0, 0), cB, voffB); PG8_STAGE(PG8_SA(0, 0), cA, voffA); PG8_STAGE(PG8_SB(0, 1), cB + hstep, voffB); PG8_STAGE(PG8_SA(0, 1), cA + hstep, voffA);
        if (wr == 1) PG8_BAR;
        PG8_WAIT_V(4); PG8_BAR;
        PG8_STAGE(PG8_SB(1, 0), cB + kstep, voffB); PG8_STAGE(PG8_SA(1, 0), cA + kstep, voffA); PG8_STAGE(PG8_SB(1, 1), cB + hstep + kstep, voffB);
        PG8_WAIT_V(6); PG8_BAR;
    }
    for (;;) {
        const bool has_next = S.next(ui + 1, nxt); const int nt = cur.nt ? cur.nt : nt0;
        const char* nA = has_next ? (const char*)g.A + (size_t)nxt.pm * tstep + nxt.kb : cA; const char* nB = has_next ? (const char*)g.Bt + (size_t)nxt.pn * tstep + nxt.kb : cB;
        for (int t = 0; t < nt; t += 2) {
            const bool last = (t == nt - 2);
            const char* a1 = cA + (size_t)(t + 1) * kstep;
            const char* a2 = last ? nA : cA + (size_t)(t + 2) * kstep; const char* b2 = last ? nB : cB + (size_t)(t + 2) * kstep;
            const char* a3 = a2 + kstep; const char* b3 = b2 + kstep;
            if (last && has_next) S.a_ready(nxt);
            if constexpr (SP2) {
            PG8_LDB(B0, 0, 0); PG8_LDB(B1, 0, 1); PG8_SCHED; PG8_LDA(At, 0, 0); PG8_STAGE(PG8_SA(1, 1), a1 + hstep, voffA);
            PG8_WAIT_V(8); PG8_WAIT_L(0); PG8_BAR; PG8_MMA(0, 0, At, B0); PG8_MMA(0, 1, At, B1); PG8_BAR; PG8_SCHED;
            PG8_LDA(At, 0, 1); PG8_STAGE(PG8_SB(0, 0), b2, voffB); PG8_STAGE(PG8_SB(0, 1), b2 + hstep, voffB); PG8_STAGE(PG8_SA(0, 0), a2, voffA);
            PG8_WAIT_V(8); PG8_WAIT_L(0); PG8_BAR; PG8_MMA(1, 0, At, B0); PG8_MMA(1, 1, At, B1); PG8_BAR; PG8_SCHED;
            PG8_LDB(B0, 1, 0); PG8_LDB(B1, 1, 1); PG8_SCHED; PG8_LDA(At, 1, 0); PG8_STAGE(PG8_SA(0, 1), a2 + hstep, voffA);
            PG8_WAIT_V(8); PG8_WAIT_L(0); PG8_BAR; PG8_MMA(0, 0, At, B0); PG8_MMA(0, 1, At, B1); PG8_BAR; PG8_SCHED;
            PG8_LDA(At, 1, 1); PG8_STAGE(PG8_SB(1, 0), b3, voffB); PG8_STAGE(PG8_SB(1, 1), b3 + hstep, voffB); PG8_STAGE(PG8_SA(1, 0), a3, voffA);
            PG8_WAIT_V(8); PG8_WAIT_L(0); PG8_BAR; PG8_MMA(1, 0, At, B0); PG8_MMA(1, 1, At, B1); PG8_BAR; PG8_SCHED;
            } else {
            PG8_LDB(B0, 0, 0); PG8_SCHED; PG8_LDA(At, 0, 0); PG8_STAGE(PG8_SA(1, 1), a1 + hstep, voffA);
            PG8_WAIT_L(8); PG8_BAR; PG8_WAIT_L(0); PG8_MMA(0, 0, At, B0); PG8_BAR; PG8_SCHED;
            PG8_LDB(B1, 0, 1); PG8_STAGE(PG8_SB(0, 0), b2, voffB);
            PG8_BAR; PG8_WAIT_L(0); PG8_MMA(0, 1, At, B1); PG8_BAR;
            PG8_LDA(At, 0, 1); PG8_STAGE(PG8_SA(0, 0), a2, voffA);
            PG8_BAR; PG8_WAIT_L(0); PG8_MMA(1, 0, At, B0); PG8_BAR; PG8_SCHED;
            PG8_STAGE(PG8_SB(0, 1), b2 + hstep, voffB);
            PG8_WAIT_V(6); PG8_BAR; PG8_MMA(1, 1, At, B1); PG8_BAR;
            PG8_LDB(B0, 1, 0); PG8_SCHED; PG8_LDA(At, 1, 0); PG8_STAGE(PG8_SA(0, 1), a2 + hstep, voffA);
            PG8_WAIT_L(8); PG8_BAR; PG8_WAIT_L(0); PG8_MMA(0, 0, At, B0); PG8_BAR; PG8_SCHED;
            PG8_LDB(B1, 1, 1); PG8_STAGE(PG8_SB(1, 0), b3, voffB);
            PG8_BAR; PG8_WAIT_L(0); PG8_MMA(0, 1, At, B1); PG8_BAR;
            PG8_LDA(At, 1, 1); PG8_STAGE(PG8_SA(1, 0), a3, voffA);
            PG8_BAR; PG8_WAIT_L(0); PG8_MMA(1, 0, At, B0); PG8_BAR; PG8_SCHED;
            PG8_STAGE(PG8_SB(1, 1), b3 + hstep, voffB);
            PG8_WAIT_V(6); PG8_BAR; PG8_MMA(1, 1, At, B1); PG8_BAR;
            }
        }
        if constexpr (ALIGN_EPI) { if (wr == 0) PG8_BAR; }
        if constexpr (!Epi::AFTER_DRAIN) { E(acc, cur, wr, wc, fr, fq); S.done(cur); }
        if (!has_next) break;
#pragma unroll
        for (int a = 0; a < 2; ++a)
#pragma unroll
            for (int b = 0; b < 2; ++b)
#pragma unroll
                for (int m = 0; m < 4; ++m)
#pragma unroll
                    for (int n = 0; n < 2; ++n) acc[a][b][m][n] = (f32x4){0.f, 0.f, 0.f, 0.f};
        cur = nxt; cA = nA; cB = nB; ++ui;
        if constexpr (ALIGN_EPI) { if (wr == 1) PG8_BAR; }
    }
    PG8_WAIT_V(0);
    if constexpr (!ALIGN_EPI) { if (wr == 0) PG8_BAR; }
    PG8_BAR;
    if constexpr (Epi::AFTER_DRAIN) { E.fused(acc, cur, wr, wc, fr, fq, lds, wid, lane); S.done(cur); }
#undef PG8_SA
#undef PG8_SB
#undef PG8_STAGE
#undef PG8_LDA
#undef PG8_LDB
#undef PG8_MMA
#undef PG8_WAIT_V
#undef PG8_WAIT_L
#undef PG8_BAR
#undef PG8_SCHED
}
}

#ifndef PG8_SP2
#define PG8_SP2 true
#endif

constexpr int DM = 2048, NB = 4, SEQ = 4096, DEPTH = 4, CTXL = 256;
constexpr int ML = NB * SEQ, MC = NB * CTXL, MA = ML + MC;
constexpr int OFF_K = 1024, OFF_V = 1152, OFF_S = 1280, OFF_GU = 1792, OFF_GV = 2304, N_IN = 2816;
constexpr int SSM_W = 512, GMLP_W = 512, DFF = 5632, NUP = 2 * DFF, NMOD = 6 * DM, NSH = N_IN + NUP;
constexpr float NORM_EPS = 1e-6f;

constexpr size_t MiB = 1u << 20;
constexpr size_t WS_CTL = 0, CTL_ZERO_BYTES = 1 * MiB;
constexpr size_t WS_MOD = 1 * MiB;
constexpr size_t WS_SA = 2 * MiB;
constexpr size_t WS_SBBR = 3 * MiB, WS_SBBI = 4 * MiB;
constexpr size_t WS_ROPE = 5 * MiB;
constexpr size_t WS_GSV = 6 * MiB;
constexpr size_t WS_SHW = 7 * MiB;
constexpr size_t WS_SHWP = 9 * MiB;
constexpr size_t WS_SSQ = 44 * MiB;
constexpr size_t WS_APOW = 49 * MiB;
constexpr size_t WS_KL = 52 * MiB;
constexpr size_t WS_PT = 54 * MiB;
constexpr size_t WS_ET = 70 * MiB;
constexpr size_t WS_CS = 86 * MiB;
constexpr size_t WS_CY = 120 * MiB;
constexpr size_t WS_WSB = 137 * MiB;
constexpr size_t WS_W = 138 * MiB;
constexpr size_t W_IN_B = (size_t)N_IN * DM * 2, W_OUT_B = (size_t)DM * DM * 2, W_UP_B = (size_t)NUP * DM * 2, W_DN_B = (size_t)DM * DFF * 2, W_GLU_B = (size_t)SSM_W * SSM_W * 2;
constexpr size_t W_LAYER_B = W_IN_B + W_OUT_B + W_UP_B + W_DN_B + W_GLU_B;
constexpr size_t WS_XS = WS_W + ((DEPTH * W_LAYER_B + MiB - 1) / MiB) * MiB;
constexpr size_t WS_A = WS_XS + (size_t)MA * DM * 4;
constexpr size_t WS_Z = WS_A + (size_t)MA * DM * 2;
constexpr size_t WS_CAT = WS_Z + (size_t)MA * N_IN * 2;
constexpr size_t WS_GS = WS_CAT + (size_t)MA * DM * 2;
constexpr size_t WS_ACT = WS_GS + (size_t)MA * 512 * 2;
constexpr size_t WS_EG = WS_ACT + (size_t)MA * DFF * 2;
constexpr size_t WS_EV = WS_EG + (size_t)68 * 44 * 4 * 128 * 4;
constexpr size_t WS_SLAB = WS_EV + (size_t)68 * 44 * 2 * 128 * 4;
constexpr size_t WS_RSTD = WS_SLAB + (size_t)8 * MC * DM * 4;
constexpr size_t WS_END2 = WS_RSTD + (size_t)2 * MA * 4;
static_assert(WS_SHW + (size_t)DEPTH * 5 * NSH * 4 <= WS_SHWP && WS_SHWP + (size_t)32 * DEPTH * 5 * NSH * 4 <= WS_SSQ && WS_SSQ + (size_t)2 * MA * 32 * 4 <= WS_APOW, "d_ws map");
constexpr int CW_BAR = 4096;

constexpr int RING_OFF = 0, RING_BYTES = 131072;
constexpr int RT_OFF = 131072, EDG_OFF = RT_OFF + 1024;
constexpr int RT_OFF_UNUSED = 0;
constexpr int LDSCTL_OFF = 135168, MISC_OFF = LDSCTL_OFF + 320;
constexpr int ROPE_OFF = 136192, ROPE_STRIDE = 36;
constexpr int LDS_BYTES = 154624;
constexpr int NWAVES = 8;

#define GAS __attribute__((address_space(1)))
#define LAS __attribute__((address_space(3)))
typedef unsigned short bf16;
typedef unsigned v4u __attribute__((ext_vector_type(4)));
typedef unsigned v2u __attribute__((ext_vector_type(2)));
typedef float f32x4 __attribute__((ext_vector_type(4)));
typedef float f32x2 __attribute__((ext_vector_type(2)));
#define RLX_AGENT __ATOMIC_RELAXED, __HIP_MEMORY_SCOPE_AGENT
#define LDS_WAIT() asm volatile("s_waitcnt lgkmcnt(0)" ::: "memory")
#define VM_WAIT() asm volatile("s_waitcnt vmcnt(0)" ::: "memory")
#define WG_BAR() asm volatile("s_waitcnt lgkmcnt(0)\n\ts_barrier" ::: "memory")
typedef float f32x2_cv __attribute__((ext_vector_type(2))); typedef __bf16 bf16x2_cv __attribute__((ext_vector_type(2)));
__device__ __forceinline__ unsigned pk2(float lo, float hi) { f32x2_cv v = {lo, hi}; bf16x2_cv b = __builtin_convertvector(v, bf16x2_cv); return __builtin_bit_cast(unsigned, b); }
__device__ __forceinline__ unsigned f2bf(float f) { return pk2(f, 0.f) & 0xffffu; }
__device__ __forceinline__ float bflo(unsigned w) { return __uint_as_float(w << 16); }
__device__ __forceinline__ float bfhi(unsigned w) { return __uint_as_float(w & 0xffff0000u); }
__device__ __forceinline__ float bf2f(bf16 h) { return __uint_as_float((unsigned)h << 16); }
__device__ __forceinline__ float fexp(float x) { return __builtin_amdgcn_exp2f(x * 1.4426950408889634f); }
__device__ __forceinline__ float frcp(float x) { return __builtin_amdgcn_rcpf(x); }
__device__ __forceinline__ float gelu_tanh(float x) { const float u = 0.7978845608028654f * (x + 0.044715f * x * x * x); const float e = fexp(2.f * u); return x - x * frcp(e + 1.f); }
__device__ __forceinline__ float sigmoidf(float x) { return frcp(1.f + fexp(-x)); }
__device__ __forceinline__ float wave_sum(float v) {
    v += __int_as_float(__builtin_amdgcn_mov_dpp(__float_as_int(v), 0xB1, 0xf, 0xf, false));
    v += __int_as_float(__builtin_amdgcn_mov_dpp(__float_as_int(v), 0x4E, 0xf, 0xf, false));
    v += __int_as_float(__builtin_amdgcn_mov_dpp(__float_as_int(v), 0x141, 0xf, 0xf, false));
    v += __int_as_float(__builtin_amdgcn_mov_dpp(__float_as_int(v), 0x140, 0xf, 0xf, false));
    { auto r = __builtin_amdgcn_permlane16_swap(__float_as_uint(v), __float_as_uint(v), false, false); v = __uint_as_float(r[0]) + __uint_as_float(r[1]); }
    { auto r = __builtin_amdgcn_permlane32_swap(__float_as_uint(v), __float_as_uint(v), false, false); v = __uint_as_float(r[0]) + __uint_as_float(r[1]); }
    return v;
}

#define XB_TMO      128
#define XB_XCNT(j)  (256  + 64 * (j))
#define XB_XSUB(j)  (1280 + 64 * (j))
#define XB_XGEN(j)  (2304 + 64 * (j))
#define XB_TOP      3328
#define XB_TOPGEN   3392
#define XCD_BAR_WORDS 3456
#define XB_SPIN_CAP (1u << 18)

__device__ __forceinline__ unsigned xb_ld(unsigned* p)              { return __hip_atomic_load(p, __ATOMIC_RELAXED, __HIP_MEMORY_SCOPE_AGENT); }
__device__ __forceinline__ unsigned xb_add(unsigned* p, unsigned v) { return __hip_atomic_fetch_add(p, v, __ATOMIC_RELAXED, __HIP_MEMORY_SCOPE_AGENT); }
__device__ __forceinline__ unsigned xb_xcc_id() { return (unsigned)__builtin_amdgcn_s_getreg((3 << 11) | 20) & 0xFu; }
#define XB_SPIN(cond, bar) do { unsigned _sp = 0; while (cond) { __builtin_amdgcn_s_sleep(1); \
    if ((++_sp & 255u) == 0u) { if (xb_ld(&(bar)[XB_TMO])) break; if (_sp > XB_SPIN_CAP) { atomicAdd(&(bar)[XB_TMO], 1u); break; } } } } while (0)

struct XcdBarrier {
    unsigned* bar; unsigned x;
    volatile LAS unsigned* st;
};

__device__ __forceinline__ XcdBarrier xcd_barrier_post(unsigned* bar, volatile LAS unsigned* st) {
    XcdBarrier b; b.bar = bar; b.x = xb_xcc_id(); b.st = st;
    if (threadIdx.x == 0) (void)xb_add(&bar[XB_XCNT(b.x)], 1u);
    return b;
}
__device__ __forceinline__ void xcd_barrier_complete(unsigned* bar, unsigned x, unsigned& nloc, unsigned& nx) {
    const unsigned G = gridDim.x * gridDim.y * gridDim.z;
    unsigned sum, cnt, mine, sp = 0u;
    for (;;) {
        sum = 0u; cnt = 0u; mine = 0u;
#pragma unroll
        for (unsigned j = 0; j < 16; ++j) { const unsigned c = xb_ld(&bar[XB_XCNT(j)]); sum += c; cnt += (c > 0u) ? 1u : 0u; mine = (j == x) ? c : mine; }
        if (sum == G) break;
        __builtin_amdgcn_s_sleep(1);
        if ((++sp & 255u) == 0u) { if (xb_ld(&bar[XB_TMO])) break; if (sp > XB_SPIN_CAP) { atomicAdd(&bar[XB_TMO], 1u); break; } }
    }
    nloc = mine > 0u ? mine : 1u; nx = cnt > 0u ? cnt : 1u;
}

__device__ __forceinline__ void xcd_barrier(const XcdBarrier& b) {
    asm volatile("s_waitcnt vmcnt(0)" ::: "memory");
    __syncthreads();
    if (threadIdx.x == 0) {
        unsigned* bar = b.bar;
        __builtin_amdgcn_s_waitcnt(0);
        unsigned nloc = b.st[0], nx = b.st[1];
        if (nloc == 0u) { xcd_barrier_complete(bar, b.x, nloc, nx); b.st[0] = nloc; b.st[1] = nx; }
        const unsigned old = xb_add(&bar[XB_XSUB(b.x)], 1u);
        const unsigned gen = old / nloc;
        if (old + 1u == (gen + 1u) * nloc) {
            __builtin_amdgcn_fence(__ATOMIC_RELEASE, "agent");
            asm volatile("s_waitcnt vmcnt(0)" ::: "memory");
            const unsigned og = xb_add(&bar[XB_TOP], 1u);
            const unsigned tg = og / nx;
            if (og + 1u == (tg + 1u) * nx) xb_add(&bar[XB_TOPGEN], 1u);
            else XB_SPIN(xb_ld(&bar[XB_TOPGEN]) == tg, bar);
            __builtin_amdgcn_fence(__ATOMIC_ACQUIRE, "agent");
            xb_add(&bar[XB_XGEN(b.x)], 1u);
            asm volatile("s_waitcnt vmcnt(0)" ::: "memory");
        } else {
            XB_SPIN(xb_ld(&bar[XB_XGEN(b.x)]) == gen, bar);
            __builtin_amdgcn_fence(__ATOMIC_ACQUIRE, "agent");
            asm volatile("s_waitcnt vmcnt(0)" ::: "memory");
        }
    }
    __syncthreads();
}


enum { I_X = 0, I_C, I_CTX, I_CCTX, I_WADA, I_BADA, I_GMIX, I_GFFN, I_WIN, I_WOUT, I_SINK, I_LRE, I_LIM, I_LDT, I_BRE, I_BIM, I_CRE, I_CIM, I_SD, I_WGLU, I_BGLU,
       I_LNG, I_LNB, I_WS, I_BS, I_WUP, I_CW, I_CB, I_WDN, I_GFIN, N_INPUTS };
struct Args { const float* in[N_INPUTS]; float* out; unsigned char* ws; int ph_lo, ph_hi; };
static_assert(sizeof(Args) == N_INPUTS * 8 + 8 + 8 + 8, "Args has no padding");
struct Frame { LAS unsigned char* lds; int tid, lane, wave, G, bid, gw, NGW, gws, gt, NGT; };

__device__ __forceinline__ bf16* w_in_t(unsigned char* ws, int l) { return (bf16*)(ws + WS_W + (size_t)l * W_LAYER_B); }
__device__ __forceinline__ bf16* w_out_t(unsigned char* ws, int l) { return (bf16*)(ws + WS_W + (size_t)l * W_LAYER_B + W_IN_B); }
__device__ __forceinline__ bf16* w_up_t(unsigned char* ws, int l) { return (bf16*)(ws + WS_W + (size_t)l * W_LAYER_B + W_IN_B + W_OUT_B); }
__device__ __forceinline__ bf16* w_dn_t(unsigned char* ws, int l) { return (bf16*)(ws + WS_W + (size_t)l * W_LAYER_B + W_IN_B + W_OUT_B + W_UP_B); }
__device__ __forceinline__ bf16* w_glu_t(unsigned char* ws, int l) { return (bf16*)(ws + WS_W + (size_t)l * W_LAYER_B + W_IN_B + W_OUT_B + W_UP_B + W_DN_B); }
__device__ __forceinline__ int mod_row(int r) { return r < ML ? (r >> 12) : 4; }

struct TrItem { const float* W; bf16* WT; const float* sh; float* shp; int K, N, item, upperm; };
__device__ __forceinline__ void tr_load(const TrItem& d, int lane, float (&v)[32]) {
    const int nblk = d.N / 32, kb = d.item / nblk, nb = d.item % nblk, k0 = 64 * kb, n0 = 32 * nb;
#pragma unroll
    for (int i = 0; i < 32; ++i) v[i] = d.W[(size_t)(k0 + 2 * i + (lane >> 5)) * d.N + n0 + (lane & 31)];
}
__device__ __forceinline__ void tr_finish(const TrItem& d, LAS float* scr, int lane, const float (&v)[32]) {
    const int K = d.K, nblk = d.N / 32, kb = d.item / nblk, nb = d.item % nblk, k0 = 64 * kb, n0 = 32 * nb;
    const int n0o = !d.upperm ? n0 : (n0 < DFF ? 256 * (n0 >> 7) + (n0 & 127) : 256 * ((n0 - DFF) >> 7) + 128 + ((n0 - DFF) & 127));
#pragma unroll
    for (int i = 0; i < 32; ++i) scr[(2 * i + (lane >> 5)) * 33 + (lane & 31)] = v[i];
    if (d.sh) {
#pragma unroll
        for (int m = 0; m < 5; ++m) scr[64 * 33 + m * 64 + lane] = d.sh[(size_t)m * NMOD + k0 + lane]; }
    LDS_WAIT(); asm volatile("" ::: "memory");
    const int c = lane & 7;
#pragma unroll
    for (int j = 0; j < 4; ++j) { const int n = (lane >> 3) + 8 * j; const LAS float* s = scr + (8 * c) * 33 + n;
        v4u o; o.x = pk2(s[0 * 33], s[1 * 33]); o.y = pk2(s[2 * 33], s[3 * 33]); o.z = pk2(s[4 * 33], s[5 * 33]); o.w = pk2(s[6 * 33], s[7 * 33]);
        *(GAS v4u*)(d.WT + (size_t)(n0o + n) * K + k0 + 8 * c) = o; }
    if (d.sh) { const int n = lane & 31, hf = lane >> 5; float p[5] = {0.f, 0.f, 0.f, 0.f, 0.f};
#pragma unroll
        for (int i = 0; i < 32; ++i) { const float wv = scr[(32 * hf + i) * 33 + n];
#pragma unroll
            for (int m = 0; m < 5; ++m) p[m] += scr[64 * 33 + m * 64 + 32 * hf + i] * wv; }
#pragma unroll
        for (int m = 0; m < 5; ++m) { p[m] += __shfl_xor(p[m], 32); if (lane < 32) d.shp[(size_t)m * NSH + n0o + n] = p[m]; } }
    LDS_WAIT(); asm volatile("" ::: "memory");
}
__device__ __forceinline__ TrItem tr_decode_a(const Args& a, int it) {
    constexpr int I_OUT = (DM / 64) * (DM / 32), I_DN = (DFF / 64) * (DM / 32), I_GLU = (SSM_W / 64) * (SSM_W / 32), I_LA = I_OUT + I_DN + I_GLU;
    const int l = it / I_LA; int r = it % I_LA; unsigned char* ws = a.ws;
    if (r < I_OUT) return TrItem{a.in[I_WOUT] + (size_t)l * DM * DM, w_out_t(ws, l), nullptr, nullptr, DM, DM, r, 0}; r -= I_OUT;
    if (r < I_DN) return TrItem{a.in[I_WDN] + (size_t)l * DFF * DM, w_dn_t(ws, l), nullptr, nullptr, DFF, DM, r, 0}; r -= I_DN;
    return TrItem{a.in[I_WGLU] + (size_t)l * SSM_W * SSM_W, w_glu_t(ws, l), nullptr, nullptr, SSM_W, SSM_W, r, 0};
}
__device__ __forceinline__ TrItem tr_decode_b(const Args& a, int it) {
    constexpr int I_IN = (DM / 64) * (N_IN / 32), I_UP = (DM / 64) * (NUP / 32), I_LB = I_IN + I_UP;
    const int l = it / I_LB; int r = it % I_LB; unsigned char* ws = a.ws; const float* modl = (const float*)(ws + WS_MOD) + (size_t)l * 5 * NMOD; float* SHWP = (float*)(ws + WS_SHWP);
    if (r < I_IN) { const int kb = r / (N_IN / 32); return TrItem{a.in[I_WIN] + (size_t)l * DM * N_IN, w_in_t(ws, l), modl, SHWP + (size_t)(kb * DEPTH + l) * 5 * NSH, DM, N_IN, r, 0}; } r -= I_IN;
    const int kb = r / (NUP / 32); return TrItem{a.in[I_WUP] + (size_t)l * DM * NUP, w_up_t(ws, l), modl + 3 * DM, SHWP + (size_t)(kb * DEPTH + l) * 5 * NSH + N_IN, DM, NUP, r, 1};
}
template <bool LIST_B> __device__ __forceinline__ void tr_run(const Frame& F, const Args& a, LAS float* scr, int nitems) {
#pragma unroll 1
    for (int it = F.gw; it < nitems; it += 2 * F.NGW) {
        const int itb = it + F.NGW; const bool hb = itb < nitems; float v0[32], v1[32];
        tr_load(LIST_B ? tr_decode_b(a, it) : tr_decode_a(a, it), F.lane, v0);
        if (hb) tr_load(LIST_B ? tr_decode_b(a, itb) : tr_decode_a(a, itb), F.lane, v1);
        tr_finish(LIST_B ? tr_decode_b(a, it) : tr_decode_a(a, it), scr, F.lane, v0);
        if (hb) tr_finish(LIST_B ? tr_decode_b(a, itb) : tr_decode_a(a, itb), scr, F.lane, v1);
    }
}
__device__ __forceinline__ void p0a_conv(const Frame& F, const Args& a) {
    { constexpr int I_LA = (DM / 64) * (DM / 32) + (DFF / 64) * (DM / 32) + (SSM_W / 64) * (SSM_W / 32);
      tr_run<false>(F, a, (LAS float*)(F.lds + RING_OFF + 65536 + F.wave * 8704), DEPTH * I_LA); }
}
__device__ __forceinline__ void p0a(const Frame& F, const Args& a) {
    unsigned char* ws = a.ws;
    { LAS float* SC = (LAS float*)(F.lds); LAS f32x4* PP = (LAS f32x4*)(F.lds + 40960); float* MOD = (float*)(ws + WS_MOD);
      const float* cc = a.in[I_C]; const float* cx = a.in[I_CCTX]; const float* wada = a.in[I_WADA]; const float* bada = a.in[I_BADA];
      for (int i = F.tid; i < 5 * DM; i += NWAVES * 64) { const int m = i >> 11, k = i & (DM - 1); const float c = m < 4 ? cc[m * DM + k] : cx[k]; SC[i] = c * sigmoidf(c); }
      WG_BAR();
#pragma unroll 1
      for (int it = F.bid; it < DEPTH * 64; it += F.G) { const int l = it >> 6, nb = it & 63, k0 = 256 * F.wave;
          const int ln = F.lane < 48 ? F.lane : 47;
          const f32x4* w = (const f32x4*)(wada + ((size_t)l * DM + k0) * NMOD + nb * 192) + ln; f32x4 acc[5];
#pragma unroll
          for (int m = 0; m < 5; ++m) acc[m] = (f32x4){0.f, 0.f, 0.f, 0.f};
#pragma unroll 32
          for (int kk = 0; kk < 256; ++kk) { const f32x4 wv = __builtin_nontemporal_load(w + (size_t)kk * (NMOD / 4));
#pragma unroll
              for (int m = 0; m < 5; ++m) acc[m] = acc[m] + wv * SC[m * DM + k0 + kk]; }
#pragma unroll
          for (int m = 0; m < 5; ++m) PP[(F.wave * 5 + m) * 64 + F.lane] = acc[m];
          WG_BAR();
          if (F.tid < 320 && (F.tid & 63) < 48) { const int m = F.tid >> 6, nn = F.tid & 63; f32x4 s = *(const f32x4*)(bada + l * NMOD + nb * 192 + 4 * nn);
#pragma unroll
              for (int w8 = 0; w8 < 8; ++w8) s = s + PP[(w8 * 5 + m) * 64 + nn];
              *(f32x4*)(MOD + (size_t)(l * 5 + m) * NMOD + nb * 192 + 4 * nn) = s; }
          WG_BAR();
      } }
    { float* SA = (float*)(ws + WS_SA); float* SBR = (float*)(ws + WS_SBBR); float* SBI = (float*)(ws + WS_SBBI); float* APW = (float*)(ws + WS_APOW);
      for (int it = F.gt; it < DEPTH * 2 * 32 * 64 * 18; it += F.NGT) { const int i = it / 18, k = it % 18;
          const double lr = a.in[I_LRE][i], li = a.in[I_LIM][i], dt = exp((double)a.in[I_LDT][i >> 6]);
          if (k < 17) { const double mk = exp(lr * dt * k), an = li * dt * k; APW[(size_t)i * 34 + 2 * k] = (float)(mk * cos(an)); APW[(size_t)i * 34 + 2 * k + 1] = (float)(mk * sin(an)); }
          else { const double mag = exp(lr * dt), ar = mag * cos(li * dt), ai = mag * sin(li * dt); const double den = lr * lr + li * li, nr = ar - 1.0;
              const double fr = (nr * lr + ai * li) / den, fi = (ai * lr - nr * li) / den;
              SA[2 * i] = (float)ar; SA[2 * i + 1] = (float)ai;
#pragma unroll 4
              for (int h = 0; h < 16; ++h) { const double br = a.in[I_BRE][(size_t)i * 16 + h], bi = a.in[I_BIM][(size_t)i * 16 + h];
                  SBR[(size_t)i * 16 + h] = (float)(fr * br - fi * bi); SBI[(size_t)i * 16 + h] = (float)(fr * bi + fi * br); } }
      } }
    { const float* wsf = a.in[I_WS]; bf16* WSB = (bf16*)(ws + WS_WSB); for (int i = F.gt; i < DEPTH * 4 * 128 * 128; i += F.NGT) WSB[i] = (bf16)f2bf(wsf[i]); }
    { float* RC = (float*)(ws + WS_ROPE); float* RS = RC + SEQ * 32;
      for (int i = F.gt; i < SEQ * 32; i += F.NGT) { const int t = i >> 5, j = i & 31, ax = j >> 4, f = j & 15;
          const float inv = powf(10000.f, -(float)f / 16.f); const float ang = (float)(ax == 0 ? (t >> 6) : (t & 63)) * inv;
          RC[i] = cosf(ang); RS[i] = sinf(ang); } }
}

__device__ __forceinline__ void p0b_conv(const Frame& F, const Args& a) {
    unsigned char* ws = a.ws; const float* MOD = (const float*)(ws + WS_MOD); float* SHWP = (float*)(ws + WS_SHWP);
    { constexpr int I_LB = (DM / 64) * (N_IN / 32) + (DM / 64) * (NUP / 32);
      tr_run<true>(F, a, (LAS float*)(F.lds + RING_OFF + F.wave * 16384), DEPTH * I_LB); }
}
__device__ __forceinline__ void p0b(const Frame& F, const Args& a) {
    unsigned char* ws = a.ws; const float* MOD = (const float*)(ws + WS_MOD);
    { float* GSV = (float*)(ws + WS_GSV);
      for (int i = F.gt; i < DEPTH * 2 * 5 * DM; i += F.NGT) { const int k = i & (DM - 1), m = (i >> 11) % 5, w = (i / (5 * DM)) & 1, l = i / (10 * DM);
          GSV[i] = (w ? a.in[I_GFFN][l * DM + k] : a.in[I_GMIX][l * DM + k]) * (1.f + MOD[(size_t)(l * 5 + m) * NMOD + (w ? 4 : 1) * DM + k]); } }
    { bf16* A = (bf16*)(ws + WS_A);
      for (int r = F.gw; r < MA; r += F.NGW) {
          const float* xrow = r < ML ? a.in[I_X] + (size_t)r * DM : a.in[I_CTX] + (size_t)(r - ML) * DM;
          const f32x4* xr = (const f32x4*)xrow + F.lane; const float* gm = a.in[I_GMIX]; const float* sc = MOD + (size_t)mod_row(r) * NMOD + DM; v2u* o = (v2u*)(A + (size_t)r * DM) + F.lane; float s = 0.f;
          f32x4 v[8], gg[8];
#pragma unroll
          for (int j = 0; j < 8; ++j) { v[j] = xr[64 * j]; gg[j] = *(const f32x4*)(gm + 4 * F.lane + 256 * j) * (*(const f32x4*)(sc + 4 * F.lane + 256 * j) + 1.f); }
#pragma unroll
          for (int j = 0; j < 8; ++j) { s += (v[j].x * v[j].x + v[j].y * v[j].y) + (v[j].z * v[j].z + v[j].w * v[j].w); const f32x4 y = v[j] * gg[j]; v2u w; w.x = pk2(y.x, y.y); w.y = pk2(y.z, y.w); o[64 * j] = w; }
          s = wave_sum(s); if (F.lane == 0) ((float*)(ws + WS_RSTD))[r] = __builtin_amdgcn_rsqf(s * (1.f / DM) + NORM_EPS);
      } }
}
__device__ __forceinline__ void p0c(const Frame& F, const Args& a) {
    unsigned char* ws = a.ws;
    { const float* SHWP = (const float*)(ws + WS_SHWP); float* SHW = (float*)(ws + WS_SHW);
      for (int i = F.gt; i < DEPTH * 5 * NSH; i += F.NGT) { float s = 0.f;
#pragma unroll 8
          for (int kb = 0; kb < 32; ++kb) s += SHWP[(size_t)kb * DEPTH * 5 * NSH + i];
          SHW[i] = s; } }

}

__device__ __forceinline__ void conv_fixup(const Frame& F, const Args& a, int l) {
    const float* EG = (const float*)(a.ws + WS_EG); const float* EV = (const float*)(a.ws + WS_EV); bf16* ACT = (bf16*)(a.ws + WS_ACT); const float* cw = a.in[I_CW] + (size_t)l * 3 * DFF; const float* cb = a.in[I_CB] + (size_t)l * DFF;
    for (int idx = F.gt; idx < 60 * 2 * DFF; idx += F.NGT) { const int c = idx % DFF, wh = (idx / DFF) & 1, bi = idx / (2 * DFF); const int pm = 16 * (bi / 15) + (bi % 15), pn = c >> 7, cc = c & 127;
        const float* ep = EG + ((size_t)(pm * 44 + pn) * 4) * 128 + cc; const float* en = EG + ((size_t)((pm + 1) * 44 + pn) * 4) * 128 + cc;
        float gm, g0, gp, vv;
        if (wh == 0) { gm = ep[2 * 128]; g0 = ep[3 * 128]; gp = en[0]; vv = EV[((size_t)(pm * 44 + pn) * 2 + 1) * 128 + cc]; }
        else { gm = ep[3 * 128]; g0 = en[0]; gp = en[128]; vv = EV[((size_t)((pm + 1) * 44 + pn) * 2) * 128 + cc]; }
        const float pre = cw[c] * gm + cw[DFF + c] * g0 + cw[2 * DFF + c] * gp + cb[c];
        ACT[(size_t)(256 * (pm + 1) - 1 + wh) * DFF + c] = (bf16)f2bf(pre * sigmoidf(pre) * vv); }
}
__device__ __forceinline__ void lat_rstd(const Frame& F, const Args& a, int stage) {
    const float* SSQ = (const float*)(a.ws + WS_SSQ) + (stage == 0 ? (size_t)MA * 32 : 0); float* RST = (float*)(a.ws + WS_RSTD) + (stage == 0 ? MA : 0);
    for (int r = F.gt; r < ML; r += F.NGT) { const f32x4* p = (const f32x4*)(SSQ + (size_t)r * 32); f32x4 s = p[0];
#pragma unroll
        for (int j = 1; j < 8; ++j) s = s + p[j];
        RST[r] = __builtin_amdgcn_rsqf(((s.x + s.y) + (s.z + s.w)) * (1.f / DM) + NORM_EPS); }
}
__device__ __forceinline__ void ctx_reduce(const Frame& F, const Args& a, int l, int stage) {
    const float* SL = (const float*)(a.ws + WS_SLAB); float* XS = (float*)(a.ws + WS_XS); bf16* A = (bf16*)(a.ws + WS_A); const int nks = 8;
    const float* gate = (const float*)(a.ws + WS_MOD) + (size_t)(l * 5 + 4) * NMOD + (stage == 0 ? 2 : 5) * DM;
    const float* gsn = (const float*)(a.ws + WS_GSV) + (size_t)((stage == 0 ? l * 2 + 1 : (l + 1) * 2) * 5 + 4) * DM;
    float* RST = (float*)(a.ws + WS_RSTD) + (stage == 0 ? MA : 0);
    for (int r = F.gw; r < MC; r += F.NGW) { const size_t row = (size_t)ML + r;
        const float* xr = (l == 0 && stage == 0) ? a.in[I_CTX] + (size_t)r * DM : XS + row * DM; float s = 0.f;
        f32x4 pp[8], xx[8];
#pragma unroll
        for (int j = 0; j < 8; ++j) { const int k = 4 * F.lane + 256 * j; pp[j] = *(const f32x4*)(SL + (size_t)r * DM + k); xx[j] = *(const f32x4*)(xr + k);
            for (int ks = 1; ks < nks; ++ks) pp[j] = pp[j] + *(const f32x4*)(SL + ((size_t)ks * MC + r) * DM + k); }
#pragma unroll
        for (int j = 0; j < 8; ++j) { const int k = 4 * F.lane + 256 * j; const f32x4 p = pp[j];
            const f32x4 x = xx[j] + *(const f32x4*)(gate + k) * p; *(f32x4*)(XS + row * DM + k) = x; s += (x.x * x.x + x.y * x.y) + (x.z * x.z + x.w * x.w);
            const f32x4 y = x * *(const f32x4*)(gsn + k); v2u w; w.x = pk2(y.x, y.y); w.y = pk2(y.z, y.w); *(v2u*)(A + row * DM + k) = w; }
        s = wave_sum(s); if (F.lane == 0) RST[row] = __builtin_amdgcn_rsqf(s * (1.f / DM) + NORM_EPS);
    }
}
__device__ __forceinline__ void final_norm(const Frame& F, const Args& a) {
    const float* XS = (const float*)(a.ws + WS_XS); const float* g = a.in[I_GFIN];
    f32x4 gg[8];
#pragma unroll
    for (int j = 0; j < 8; ++j) gg[j] = *(const f32x4*)(g + 4 * F.lane + 256 * j);
#pragma unroll 1
    for (int r = F.gw; r < ML; r += 2 * F.NGW) {
        const int r1 = r + F.NGW < ML ? r + F.NGW : r; f32x4 v0[8], v1[8]; float s0 = 0.f, s1 = 0.f;
        const f32x4* x0 = (const f32x4*)(XS + (size_t)r * DM) + F.lane; const f32x4* x1 = (const f32x4*)(XS + (size_t)r1 * DM) + F.lane;
#pragma unroll
        for (int j = 0; j < 8; ++j) { v0[j] = x0[64 * j]; v1[j] = x1[64 * j]; }
#pragma unroll
        for (int j = 0; j < 8; ++j) { s0 += (v0[j].x * v0[j].x + v0[j].y * v0[j].y) + (v0[j].z * v0[j].z + v0[j].w * v0[j].w); s1 += (v1[j].x * v1[j].x + v1[j].y * v1[j].y) + (v1[j].z * v1[j].z + v1[j].w * v1[j].w); }
        const float rs0 = __builtin_amdgcn_rsqf(wave_sum(s0) * (1.f / DM) + NORM_EPS), rs1 = __builtin_amdgcn_rsqf(wave_sum(s1) * (1.f / DM) + NORM_EPS);
        f32x4* o0 = (f32x4*)(a.out + (size_t)r * DM) + F.lane; f32x4* o1 = (f32x4*)(a.out + (size_t)r1 * DM) + F.lane;
#pragma unroll
        for (int j = 0; j < 8; ++j) { o0[64 * j] = v0[j] * rs0 * gg[j]; o1[64 * j] = v1[j] * rs1 * gg[j]; }
    }
}
namespace att {
typedef short bf16x8 __attribute__((ext_vector_type(8)));
typedef short s16x4 __attribute__((ext_vector_type(4)));
typedef float f32x16 __attribute__((ext_vector_type(16)));
typedef unsigned u32x4 __attribute__((ext_vector_type(4)));
constexpr int SLOTB = 8192, LDS_K = 0, LDS_V = 3 * SLOTB, LDS_WS = 6 * SLOTB, LDS_OST = LDS_WS + 8 * 64 * 4, LDS_TOTAL = LDS_OST + 8 * 4096;
constexpr float C2 = 0.125f * 1.4426950408889634f, LOG2E = 1.4426950408889634f;
__device__ __forceinline__ int crow(int r, int hi) { return (r & 3) + 8 * (r >> 2) + 4 * hi; }
__device__ __forceinline__ void glds16(const void* gsrc, unsigned lds_dst) { unsigned keep;
    asm volatile("s_mov_b32 %0, m0\n\ts_mov_b32 m0, %2\n\ts_nop 0\n\tglobal_load_lds_dwordx4 %1, off\n\ts_mov_b32 m0, %0" : "=&s"(keep) : "v"(gsrc), "s"(lds_dst) : "memory"); }
typedef float f32x2_t __attribute__((ext_vector_type(2))); typedef __bf16 bf16x2_t __attribute__((ext_vector_type(2)));
__device__ __forceinline__ unsigned cvtpk_s(float lo, float hi) { f32x2_t v = {lo, hi}; bf16x2_t b = __builtin_convertvector(v, bf16x2_t); return __builtin_bit_cast(unsigned, b); }
#define ATT_SBAR() __builtin_amdgcn_sched_barrier(0)
__device__ __forceinline__ void pv2(f32x16 (&o)[2][2], int vb, const bf16x8 (&pa)[2][4]) {
#pragma unroll
    for (int d0 = 0; d0 < 2; ++d0) { s16x4 lo[4], hi[4];
#pragma unroll
        for (int ks = 0; ks < 4; ++ks) {
            asm volatile("ds_read_b64_tr_b16 %0,%1 offset:%c2" : "=&v"(lo[ks]) : "v"(vb), "i"(d0 * 4096 + ks * 1024) : "memory");
            asm volatile("ds_read_b64_tr_b16 %0,%1 offset:%c2" : "=&v"(hi[ks]) : "v"(vb), "i"(d0 * 4096 + ks * 1024 + 512) : "memory"); }
        asm volatile("s_waitcnt lgkmcnt(0)" ::: "memory"); ATT_SBAR();
#pragma unroll
        for (int ks = 0; ks < 4; ++ks) { const bf16x8 vf = (bf16x8){lo[ks][0], lo[ks][1], lo[ks][2], lo[ks][3], hi[ks][0], hi[ks][1], hi[ks][2], hi[ks][3]};
            o[0][d0] = __builtin_amdgcn_mfma_f32_32x32x16_bf16(pa[0][ks], vf, o[0][d0], 0, 0, 0);
            o[1][d0] = __builtin_amdgcn_mfma_f32_32x32x16_bf16(pa[1][ks], vf, o[1][d0], 0, 0, 0); }
    }
}
__device__ __forceinline__ void unit(LAS unsigned char* shm, const bf16* Z, bf16* CAT, float sinkv, int qrow0, int qpos0, int krow_ctx, int krow_lat, int kh, bool latent, int wid, int lane) {
    constexpr float THR = 8.f;
    const int r32 = lane & 31, hi = lane >> 5; const int head = kh * 8 + wid;
    const unsigned lds0 = (unsigned)(uintptr_t)shm;
    LAS float* wsf = (LAS float*)(shm + LDS_WS) + wid * 64;
    bf16x8 qr[2][4];
    int jlo = 0, nband = 0;
    if (latent) { const int j = qpos0 >> 6; jlo = j - 2 < 0 ? 0 : j - 2; const int jhi = j + 2 > 63 ? 63 : j + 2; nband = jhi - jlo + 1; }
    const int NT = 4 + nband;
    const size_t koff = (size_t)lane * N_IN + OFF_K + kh * 64 + wid * 8;
    const size_t voff = (size_t)(16 * (wid & 3) + (lane >> 2)) * N_IN + OFF_V + kh * 64 + (wid >> 2) * 32 + (lane & 3) * 8;
    const unsigned kdst = lds0 + LDS_K + wid * 1024, vdst = lds0 + LDS_V + wid * 1024;
#define ATT_TROW(t) ((t) < 4 ? krow_ctx + 64 * (t) : krow_lat + 64 * (jlo + (t) - 4))
#define ATT_DMA(t, slot) do { const int tr_ = ATT_TROW(t); glds16(Z + (size_t)tr_ * N_IN + koff, (unsigned)__builtin_amdgcn_readfirstlane(kdst + (slot))); glds16(Z + (size_t)tr_ * N_IN + voff, (unsigned)__builtin_amdgcn_readfirstlane(vdst + (slot))); } while (0)
    const int vb0 = (int)(lds0 + LDS_V) + ((lane >> 4) & 1) * 32 + (lane & 3) * 8 + (4 * hi + ((lane & 15) >> 2)) * 64;
    float m[2] = {0.f, 0.f}, l[2] = {0.f, 0.f}; f32x16 o[2][2]; o[0][0] = f32x16{}; o[0][1] = f32x16{}; o[1][0] = f32x16{}; o[1][1] = f32x16{};
    f32x16 negm[2]; negm[0] = f32x16{}; negm[1] = f32x16{};
    ATT_DMA(0, 0);
#pragma unroll
    for (int x = 0; x < 2; ++x) { const bf16* Qw = Z + (size_t)(qrow0 + 32 * x + r32) * N_IN + head * 64 + hi * 8;
#pragma unroll
        for (int d0 = 0; d0 < 4; ++d0) qr[x][d0] = *(const bf16x8*)(Qw + d0 * 16); }
    asm volatile("s_waitcnt vmcnt(0)" ::: "memory");
    ATT_DMA(1, SLOTB);
    int slot = 0, slot2 = 2 * SLOTB;
#pragma unroll 1
    for (int t = 0; t < NT; ++t) {
        if (t + 1 < NT) { asm volatile("s_waitcnt vmcnt(2)\n\ts_barrier" ::: "memory"); } else { asm volatile("s_waitcnt vmcnt(0)\n\ts_barrier" ::: "memory"); }
        if (t + 2 < NT) ATT_DMA(t + 2, slot2);
        f32x16 p[2][2]; p[0][0] = negm[0]; p[0][1] = negm[0]; p[1][0] = negm[1]; p[1][1] = negm[1];
        { const LAS unsigned char* kb = shm + LDS_K + slot + hi * 1024 + r32 * 16;
#pragma unroll
          for (int d0 = 0; d0 < 4; ++d0) { const bf16x8 b0 = *(const LAS bf16x8*)(kb + d0 * 2048), b1 = *(const LAS bf16x8*)(kb + d0 * 2048 + 512);
#pragma unroll
              for (int x = 0; x < 2; ++x) { p[x][0] = __builtin_amdgcn_mfma_f32_32x32x16_bf16(b0, qr[x][d0], p[x][0], 0, 0, 0); p[x][1] = __builtin_amdgcn_mfma_f32_32x32x16_bf16(b1, qr[x][d0], p[x][1], 0, 0, 0); } } }
        bf16x8 pa[2][4];
#pragma unroll
        for (int x = 0; x < 2; ++x) {
            if (t >= 4) { const int kp0 = 64 * (jlo + t - 4), qx0 = qpos0 + 32 * x;
                if (kp0 + 63 - qx0 > 128 || qx0 + 31 - kp0 > 128) {
#pragma unroll
                    for (int r = 0; r < 16; ++r) { const int d = kp0 + crow(r, hi) - (qx0 + r32); if (d > 128 || d < -128) p[x][0][r] = -INFINITY; if (d + 32 > 128 || d + 32 < -128) p[x][1][r] = -INFINITY; } } }
            float mx = __builtin_fmaxf(__builtin_fmaxf(p[x][0][0], p[x][1][0]), __builtin_fmaxf(p[x][0][1], p[x][1][1]));
#pragma unroll
            for (int r = 2; r < 16; r += 2) mx = __builtin_fmaxf(__builtin_fmaxf(mx, __builtin_fmaxf(p[x][0][r], p[x][1][r])), __builtin_fmaxf(p[x][0][r + 1], p[x][1][r + 1]));
            { auto rr = __builtin_amdgcn_permlane32_swap(__float_as_uint(mx), __float_as_uint(mx), false, false); mx = __builtin_fmaxf(__uint_as_float(rr[0]), __uint_as_float(rr[1])); }
            if (__any(t == 0 || mx > THR)) {
                const float d = t == 0 ? mx : __builtin_fmaxf(mx, 0.f), f = t == 0 ? 0.f : __builtin_amdgcn_exp2f(-d); m[x] += d; l[x] *= f;
#pragma unroll
                for (int r = 0; r < 16; ++r) { p[x][0][r] -= d; p[x][1][r] -= d; negm[x][r] = -m[x]; }
                if (t > 0) { if (hi == 0) wsf[r32] = f;
#pragma unroll
                    for (int r = 0; r < 16; ++r) { const float g = wsf[crow(r, hi)]; o[x][0][r] *= g; o[x][1][r] *= g; } } }
            float rs = 0.f;
#pragma unroll
            for (int r = 0; r < 16; ++r) { p[x][0][r] = __builtin_amdgcn_exp2f(p[x][0][r]); p[x][1][r] = __builtin_amdgcn_exp2f(p[x][1][r]); rs += p[x][0][r] + p[x][1][r]; }
            l[x] += rs;
#pragma unroll
            for (int k = 0; k < 4; ++k) { const int h2 = k >> 1, b8 = (k & 1) * 8;
                const u32x4 w = (u32x4){cvtpk_s(p[x][h2][b8 + 0], p[x][h2][b8 + 1]), cvtpk_s(p[x][h2][b8 + 2], p[x][h2][b8 + 3]), cvtpk_s(p[x][h2][b8 + 4], p[x][h2][b8 + 5]), cvtpk_s(p[x][h2][b8 + 6], p[x][h2][b8 + 7])};
                pa[x][k] = __builtin_bit_cast(bf16x8, w); }
        }
        pv2(o, vb0 + slot, pa);
        asm volatile("s_waitcnt lgkmcnt(0)" ::: "memory");
        { const int s_ = slot; slot = slot == 2 * SLOTB ? 0 : slot + SLOTB; slot2 = s_; }
    }
#undef ATT_DMA
#undef ATT_TROW
#pragma unroll
    for (int x = 0; x < 2; ++x) { float lx = l[x];
        { auto rr = __builtin_amdgcn_permlane32_swap(__float_as_uint(lx), __float_as_uint(lx), false, false); lx = __uint_as_float(rr[0]) + __uint_as_float(rr[1]); }
        lx += __builtin_amdgcn_exp2f(sinkv * LOG2E - m[x]);
        if (hi == 0) wsf[32 + r32] = lx;
        asm volatile("s_waitcnt lgkmcnt(0)" ::: "memory");
        float rli[16];
#pragma unroll
        for (int r = 0; r < 16; ++r) rli[r] = __builtin_amdgcn_rcpf(wsf[32 + crow(r, hi)]);
        bf16* Ow = CAT + (size_t)(qrow0 + 32 * x) * DM + head * 64;
        LAS bf16* stg = (LAS bf16*)(shm + LDS_OST) + wid * 2048;
#pragma unroll
        for (int r = 0; r < 16; ++r) { const int orow = crow(r, hi);
#pragma unroll
            for (int d0 = 0; d0 < 2; ++d0) stg[orow * 64 + d0 * 32 + r32] = (bf16)f2bf(o[x][d0][r] * rli[r]); }
        asm volatile("s_waitcnt lgkmcnt(0)" ::: "memory");
#pragma unroll
        for (int i = 0; i < 4; ++i) { const int row = i * 8 + (lane >> 3), ch = lane & 7; const u32x4 v = *(const LAS u32x4*)(stg + row * 64 + ch * 8); *(u32x4*)(Ow + (size_t)row * DM + ch * 8) = v; }
        asm volatile("s_waitcnt lgkmcnt(0)" ::: "memory"); }
    asm volatile("s_waitcnt lgkmcnt(0)\n\ts_barrier" ::: "memory");
}
#undef ATT_SBAR
}
__device__ __forceinline__ void attn_phase(const Frame& F, const Args& a, int l, bool with_ctx) {
    const bf16* Z = (const bf16*)(a.ws + WS_Z); bf16* CAT = (bf16*)(a.ws + WS_CAT); const float* sink = a.in[I_SINK] + l * 16;
    const int v = (F.G % 8 == 0) ? (F.bid % 8) * (F.G / 8) + F.bid / 8 : F.bid;
    const int NU = 512 + (with_ctx ? 32 : 0);
#pragma unroll 1
    for (int ui = v; ui < NU; ui += F.G) {
        const bool lat = ui < 512; const int uc = ui - 512;
        const int b = lat ? ui >> 7 : uc >> 3, kh = lat ? (ui >> 6) & 1 : (uc >> 2) & 1, qb = lat ? ui & 63 : uc & 3;
        att::unit(F.lds + RING_OFF, Z, CAT, sink[kh * 8 + F.wave], (lat ? b * SEQ : ML + b * CTXL) + qb * 64, lat ? qb * 64 : 0, ML + b * CTXL, b * SEQ, kh, lat, F.wave, F.lane);
    }
}

typedef short bf16x8_t __attribute__((ext_vector_type(8)));
__device__ __forceinline__ void s5_tables(const Frame& F, const Args& a) {
    unsigned char* ws = a.ws; const float* AP = (const float*)(ws + WS_APOW); const float* SBR = (const float*)(ws + WS_SBBR); const float* SBI = (const float*)(ws + WS_SBBI);
    const float* cre = a.in[I_CRE]; const float* cim = a.in[I_CIM];
    bf16* KL = (bf16*)(ws + WS_KL); bf16* PT = (bf16*)(ws + WS_PT); bf16* ET = (bf16*)(ws + WS_ET);
    LAS float* L = (LAS float*)(F.lds + RING_OFF);
    constexpr int DS = 6272;
    WG_BAR();
#pragma unroll 1
    for (int lg = F.bid; lg < DEPTH * 32; lg += F.G) { const int l = lg >> 5, g = lg & 31;
        for (int i = F.tid; i < 2 * DS; i += NWAVES * 64) { const int d = i / DS, r = i % DS; const int i0 = ((l * 2 + d) * 32 + g) * 64; float v;
            if (r < 2176) v = AP[(size_t)i0 * 34 + r]; else if (r < 3200) v = SBR[(size_t)i0 * 16 + r - 2176]; else if (r < 4224) v = SBI[(size_t)i0 * 16 + r - 3200];
            else if (r < 5248) v = cre[(size_t)(i0 >> 6) * 1024 + r - 4224]; else v = cim[(size_t)(i0 >> 6) * 1024 + r - 5248];
            L[i] = v; }
        WG_BAR();
        { const int d = F.tid >> 8, k = (F.tid >> 4) & 15, h = F.tid & 15; const LAS float* D = L + d * DS; float acc[16];
#pragma unroll
          for (int hp = 0; hp < 16; ++hp) acc[hp] = 0.f;
#pragma unroll 4
          for (int p = 0; p < 64; ++p) { const float pr = D[p * 34 + 2 * k], pi = D[p * 34 + 2 * k + 1], cr = D[4224 + h * 64 + p], ci = D[5248 + h * 64 + p]; const float wr = cr * pr - ci * pi, wi = cr * pi + ci * pr;
#pragma unroll
              for (int q4 = 0; q4 < 4; ++q4) { const f32x4 br = *(const LAS f32x4*)(D + 2176 + p * 16 + 4 * q4), bi = *(const LAS f32x4*)(D + 3200 + p * 16 + 4 * q4);
#pragma unroll
                  for (int e = 0; e < 4; ++e) acc[4 * q4 + e] += wr * br[e] - wi * bi[e]; } }
          if (k == 0 && d == 1) {
#pragma unroll
              for (int hp = 0; hp < 16; ++hp) L[2 * DS + h * 16 + hp] = acc[hp]; }
          WG_BAR();
          if (k == 0 && d == 0) { const float dsk = a.in[I_SD][l * SSM_W + g * 16 + h];
#pragma unroll
              for (int hp = 0; hp < 16; ++hp) acc[hp] += L[2 * DS + h * 16 + hp] + (hp == h ? dsk : 0.f); }
          if (!(k == 0 && d == 1)) { const int li = d == 0 ? 15 + k : 15 - k; v4u w0, w1;
              w0.x = pk2(acc[0], acc[1]); w0.y = pk2(acc[2], acc[3]); w0.z = pk2(acc[4], acc[5]); w0.w = pk2(acc[6], acc[7]); w1.x = pk2(acc[8], acc[9]); w1.y = pk2(acc[10], acc[11]); w1.z = pk2(acc[12], acc[13]); w1.w = pk2(acc[14], acc[15]);
              v4u* o = (v4u*)(KL + (((size_t)lg * 31 + li) * 16 + h) * 16); o[0] = w0; o[1] = w1; } }
#pragma unroll 1
        for (int e8 = F.tid; e8 < 8192; e8 += NWAVES * 64) { unsigned pw[4], ew[4];
#pragma unroll
            for (int j = 0; j < 4; ++j) { float pv[2], ev[2];
#pragma unroll
                for (int u = 0; u < 2; ++u) { const int idx = e8 * 8 + 2 * j + u;
                    { const int kk = idx & 255, tp = kk >> 4, hp = kk & 15, s = idx >> 8, d = s >> 7, p = (s >> 1) & 63, ri = s & 1; const LAS float* D = L + d * DS; const int k = d ? tp : 15 - tp;
                      const float pr = D[p * 34 + 2 * k], pi = D[p * 34 + 2 * k + 1], br = D[2176 + p * 16 + hp], bi = D[3200 + p * 16 + hp]; pv[u] = ri ? pr * bi + pi * br : pr * br - pi * bi; }
                    { const int s = idx & 255, d = s >> 7, p = (s >> 1) & 63, ri = s & 1, th = idx >> 8, t = th >> 4, h = th & 15; const LAS float* D = L + d * DS; const int k = d ? 16 - t : t + 1;
                      const float pr = D[p * 34 + 2 * k], pi = D[p * 34 + 2 * k + 1], cr = D[4224 + h * 64 + p], ci = D[5248 + h * 64 + p]; ev[u] = ri ? -(cr * pi + ci * pr) : cr * pr - ci * pi; } }
                pw[j] = pk2(pv[0], pv[1]); ew[j] = pk2(ev[0], ev[1]); }
            *(v4u*)(PT + (size_t)lg * 65536 + e8 * 8) = (v4u){pw[0], pw[1], pw[2], pw[3]}; *(v4u*)(ET + (size_t)lg * 65536 + e8 * 8) = (v4u){ew[0], ew[1], ew[2], ew[3]}; }
        WG_BAR();
    }
}
__device__ __forceinline__ void s5_stage_u(const Frame& F, const bf16* Z, int g, int c0, int nc, LAS unsigned char* dst) {
    v4u w[8];
#pragma unroll
    for (int j = 0; j < 8; ++j) { const int p0 = F.tid + j * NWAVES * 64, p = p0 < nc * 32 ? p0 : nc * 32 - 1; const int r = p >> 1, hf = p & 1; w[j] = *(const v4u*)(Z + (size_t)(c0 * 16 + r) * N_IN + OFF_S + g * 16 + hf * 8); }
#pragma unroll
    for (int j = 0; j < 8; ++j) { const int p = F.tid + j * NWAVES * 64; if (p < nc * 32) { const int r = p >> 1, hf = p & 1; *(LAS v4u*)(dst + (r >> 4) * 528 + (r & 15) * 32 + hf * 16) = w[j]; } }
}
__device__ __forceinline__ void s5_chunk_states(const Frame& F, const Args& a, int l) {
    const bf16* Z = (const bf16*)(a.ws + WS_Z); const bf16* PT = (const bf16*)(a.ws + WS_PT); float* CS = (float*)(a.ws + WS_CS);
    const int n16 = F.lane & 15, kq = F.lane >> 4; LAS unsigned char* UL = F.lds + RING_OFF;
#pragma unroll 1
    for (int it = F.bid; it < 384; it += F.G) {
        const bool lat = it < 256; const int g = it & 31, c0 = lat ? 128 * (it >> 5) : 1024 + 16 * ((it - 256) >> 5), nct = lat ? 8 : 1; const int lg = l * 32 + g;
        s5_stage_u(F, Z, g, c0, nct * 16, UL); asm volatile("" ::: "memory");
        bf16x8_t af[2][8];
#pragma unroll
        for (int q = 0; q < 2; ++q)
#pragma unroll
            for (int ks = 0; ks < 8; ++ks) af[q][ks] = *(const bf16x8_t*)(PT + ((size_t)lg * 256 + 32 * F.wave + 16 * q + n16) * 256 + 32 * ks + 8 * kq);
        WG_BAR();
#pragma unroll 2
        for (int ct = 0; ct < nct; ++ct) { const int chunk = c0 + 16 * ct + n16; bf16x8_t bfr[8];
#pragma unroll
            for (int ks = 0; ks < 8; ++ks) bfr[ks] = *(const LAS bf16x8_t*)(UL + (16 * ct + n16) * 528 + (2 * ks + (kq >> 1)) * 32 + (kq & 1) * 16);
            f32x4 acc0 = (f32x4){0.f, 0.f, 0.f, 0.f}, acc1 = acc0;
#pragma unroll
            for (int ks = 0; ks < 8; ++ks) { acc0 = __builtin_amdgcn_mfma_f32_16x16x32_bf16(af[0][ks], bfr[ks], acc0, 0, 0, 0); acc1 = __builtin_amdgcn_mfma_f32_16x16x32_bf16(af[1][ks], bfr[ks], acc1, 0, 0, 0); }
            float* o = CS + ((size_t)chunk * 32 + g) * 256 + 32 * F.wave + 4 * kq; *(f32x4*)o = acc0; *(f32x4*)(o + 16) = acc1; }
        WG_BAR();
    }
}
__device__ __forceinline__ void s5_carries(const Frame& F, const Args& a, int l) {
    const float* CS = (const float*)(a.ws + WS_CS); unsigned* CY = (unsigned*)(a.ws + WS_CY); const float* AP = (const float*)(a.ws + WS_APOW);
    for (int ci = F.gws; ci < 256; ci += F.NGW) {
        const int dir = ci & 1, g = (ci >> 1) & 31, b = ci >> 6; const int i = ((l * 2 + dir) * 32 + g) * 64 + F.lane;
        const float ar = AP[((size_t)i * 17 + 16) * 2], ai = AP[((size_t)i * 17 + 16) * 2 + 1]; float hr = 0.f, hi = 0.f;
        const size_t lane_off = (size_t)g * 256 + dir * 128 + 2 * F.lane;
#define S5_CIDX(step) ((step) < 16 ? 1024 + 16 * b + (dir ? 15 - (step) : (step)) : 256 * b + (dir ? 271 - (step) : (step) - 16))
        f32x2 sa[34], sb[34];
#pragma unroll
        for (int j = 0; j < 34; ++j) sa[j] = *(const f32x2*)(CS + (size_t)S5_CIDX(j) * 8192 + lane_off);
#pragma unroll 1
        for (int s0 = 0; s0 < 272; s0 += 68) {
#pragma unroll
            for (int j = 0; j < 34; ++j) sb[j] = *(const f32x2*)(CS + (size_t)S5_CIDX(s0 + 34 + j) * 8192 + lane_off);
#pragma unroll
            for (int j = 0; j < 34; ++j) { CY[((size_t)S5_CIDX(s0 + j) * 8192 + lane_off) >> 1] = pk2(hr, hi); const float nr = ar * hr - ai * hi + sa[j].x, ni = ar * hi + ai * hr + sa[j].y; hr = nr; hi = ni; }
            if (s0 + 68 < 272) {
#pragma unroll
                for (int j = 0; j < 34; ++j) sa[j] = *(const f32x2*)(CS + (size_t)S5_CIDX(s0 + 68 + j) * 8192 + lane_off); }
#pragma unroll
            for (int j = 0; j < 34; ++j) { CY[((size_t)S5_CIDX(s0 + 34 + j) * 8192 + lane_off) >> 1] = pk2(hr, hi); const float nr = ar * hr - ai * hi + sb[j].x, ni = ar * hi + ai * hr + sb[j].y; hr = nr; hi = ni; }
        }
#undef S5_CIDX
    }
}
__device__ __forceinline__ void s5_outputs(const Frame& F, const Args& a, int l, bool with_ctx) {
    const bf16* Z = (const bf16*)(a.ws + WS_Z); const bf16* KL = (const bf16*)(a.ws + WS_KL); const bf16* ET = (const bf16*)(a.ws + WS_ET); const bf16* CY = (const bf16*)(a.ws + WS_CY); bf16* GS = (bf16*)(a.ws + WS_GS);
    const int n16 = F.lane & 15, kq = F.lane >> 4; const int NI = with_ctx ? 384 : 256; LAS unsigned char* UL = F.lds + RING_OFF; LAS unsigned char* CL = UL + 128 * 528;
#pragma unroll 1
    for (int it = F.bid; it < NI; it += F.G) {
        const bool lat = it < 256; const int g = it & 31, c0 = lat ? 128 * (it >> 5) : 1024 + 16 * ((it - 256) >> 5), nct = lat ? 8 : 1; const int lg = l * 32 + g;
        s5_stage_u(F, Z, g, c0, nct * 16, UL);
        { v4u w[8];
#pragma unroll
          for (int j = 0; j < 8; ++j) { const int p0 = F.tid + j * NWAVES * 64, p = p0 < nct * 16 * 32 ? p0 : nct * 16 * 32 - 1; const int c = p >> 5, pc = p & 31; w[j] = *(const v4u*)(CY + ((size_t)(c0 + c) * 32 + g) * 256 + pc * 8); }
#pragma unroll
          for (int j = 0; j < 8; ++j) { const int p = F.tid + j * NWAVES * 64; if (p < nct * 16 * 32) { const int c = p >> 5, pc = p & 31; *(LAS v4u*)(CL + c * 528 + pc * 16) = w[j]; } } }
        asm volatile("" ::: "memory");
        bf16x8_t af[2][16];
#pragma unroll
        for (int q = 0; q < 2; ++q) { const int t = 2 * F.wave + q;
#pragma unroll
            for (int ks = 0; ks < 8; ++ks) { const int tp = 2 * ks + (kq >> 1); af[q][ks] = *(const bf16x8_t*)(KL + (((size_t)lg * 31 + (t - tp + 15)) * 16 + n16) * 16 + 8 * (kq & 1)); }
#pragma unroll
            for (int ks = 0; ks < 8; ++ks) af[q][8 + ks] = *(const bf16x8_t*)(ET + ((size_t)lg * 256 + t * 16 + n16) * 256 + 32 * ks + 8 * kq); }
        WG_BAR();
#pragma unroll 1
        for (int ct = 0; ct < nct; ++ct) { const int chunk = c0 + 16 * ct + n16; bf16x8_t bfr[16];
#pragma unroll
            for (int ks = 0; ks < 8; ++ks) bfr[ks] = *(const LAS bf16x8_t*)(UL + (16 * ct + n16) * 528 + (2 * ks + (kq >> 1)) * 32 + (kq & 1) * 16);
#pragma unroll
            for (int ks = 0; ks < 8; ++ks) bfr[8 + ks] = *(const LAS bf16x8_t*)(CL + (16 * ct + n16) * 528 + ks * 64 + kq * 16);
            f32x4 acc0 = (f32x4){0.f, 0.f, 0.f, 0.f}, acc1 = acc0;
#pragma unroll
            for (int ks = 0; ks < 16; ++ks) { acc0 = __builtin_amdgcn_mfma_f32_16x16x32_bf16(af[0][ks], bfr[ks], acc0, 0, 0, 0); acc1 = __builtin_amdgcn_mfma_f32_16x16x32_bf16(af[1][ks], bfr[ks], acc1, 0, 0, 0); }
            { const size_t r0 = (size_t)(chunk * 16 + 2 * F.wave); v2u w0, w1;
              w0.x = pk2(gelu_tanh(acc0[0]), gelu_tanh(acc0[1])); w0.y = pk2(gelu_tanh(acc0[2]), gelu_tanh(acc0[3])); w1.x = pk2(gelu_tanh(acc1[0]), gelu_tanh(acc1[1])); w1.y = pk2(gelu_tanh(acc1[2]), gelu_tanh(acc1[3]));
              *(v2u*)(GS + r0 * SSM_W + g * 16 + 4 * kq) = w0; *(v2u*)(GS + (r0 + 1) * SSM_W + g * 16 + 4 * kq) = w1; }
        }
        WG_BAR();
    }
}
__device__ __forceinline__ void gmlp_phase(const Frame& F, const Args& a, int l, bool with_ctx) {
    const bf16* Z = (const bf16*)(a.ws + WS_Z); bf16* CAT = (bf16*)(a.ws + WS_CAT); const bf16* WSB = (const bf16*)(a.ws + WS_WSB) + (size_t)l * 4 * 128 * 128;
    const float* lg = a.in[I_LNG] + l * GMLP_W; const float* lb = a.in[I_LNB] + l * GMLP_W; const float* bs = a.in[I_BS] + l * 512;
    constexpr int RS = 1056; const int n16 = F.lane & 15, kq = F.lane >> 4, q4 = (F.lane & 15) >> 2, p4 = F.lane & 3;
    const unsigned lds0 = (unsigned)(uintptr_t)(F.lds + RING_OFF);
    const int NU = with_ctx ? 136 : 128;
    float lgv[8], lbv[8];
#pragma unroll
    for (int j = 0; j < 8; ++j) { lgv[j] = lg[8 * F.lane + j]; lbv[j] = lb[8 * F.lane + j]; }
#pragma unroll 1
    for (int u = F.G - 1 - F.bid; u < NU; u += F.G) {
        const int rb = u * 128;
        v4u wrow[16];
#pragma unroll
        for (int jj = 0; jj < 16; ++jj) wrow[jj] = *(const v4u*)(Z + (size_t)(rb + 16 * F.wave + jj) * N_IN + OFF_GV + 8 * F.lane);
#pragma unroll
        for (int jj = 0; jj < 16; ++jj) { const int j = 16 * F.wave + jj;
            const v4u w = wrow[jj]; float e[8];
            e[0] = gelu_tanh(bflo(w.x)); e[1] = gelu_tanh(bfhi(w.x)); e[2] = gelu_tanh(bflo(w.y)); e[3] = gelu_tanh(bfhi(w.y)); e[4] = gelu_tanh(bflo(w.z)); e[5] = gelu_tanh(bfhi(w.z)); e[6] = gelu_tanh(bflo(w.w)); e[7] = gelu_tanh(bfhi(w.w));
            float s = 0.f;
#pragma unroll
            for (int k = 0; k < 8; ++k) s += e[k];
            const float mu = wave_sum(s) * (1.f / GMLP_W); float qq = 0.f;
#pragma unroll
            for (int k = 0; k < 8; ++k) { e[k] -= mu; qq += e[k] * e[k]; }
            const float rstd = __builtin_amdgcn_rsqf(wave_sum(qq) * (1.f / GMLP_W) + NORM_EPS);
#pragma unroll
            for (int k = 0; k < 8; ++k) e[k] = e[k] * rstd * lgv[k] + lbv[k];
            v4u o; o.x = pk2(e[0], e[1]); o.y = pk2(e[2], e[3]); o.z = pk2(e[4], e[5]); o.w = pk2(e[6], e[7]);
            *(LAS v4u*)(F.lds + RING_OFF + j * RS + 16 * F.lane) = o; }
        asm volatile("s_waitcnt lgkmcnt(0)\n\ts_barrier" ::: "memory");
#pragma unroll 1
        for (int g = 0; g < 4; ++g) {
            bf16x8_t af[4];
#pragma unroll
            for (int ks = 0; ks < 4; ++ks) af[ks] = *(const bf16x8_t*)(WSB + ((size_t)g * 128 + 16 * F.wave + n16) * 128 + 32 * ks + 8 * kq);
            const f32x4 bsv = *(const f32x4*)(bs + g * 128 + 16 * F.wave + 4 * kq);
            unsigned guv[8][4];
#pragma unroll
            for (int c8 = 0; c8 < 8; ++c8)
#pragma unroll
                for (int e = 0; e < 4; ++e) guv[c8][e] = (unsigned)Z[(size_t)(rb + 16 * F.wave + 4 * kq + e) * N_IN + OFF_GU + 16 * (g * 8 + c8) + n16];
#pragma unroll
            for (int c8 = 0; c8 < 8; ++c8) { const int ct = g * 8 + c8;
                const unsigned ab = lds0 + RS * (8 * kq + q4) + 32 * ct + 8 * p4;
                typedef short s16x4_t __attribute__((ext_vector_type(4))); s16x4_t t0[4], t1[4];
#pragma unroll
                for (int ks = 0; ks < 4; ++ks) { asm volatile("ds_read_b64_tr_b16 %0, %1" : "=&v"(t0[ks]) : "v"(ab + RS * 32 * ks) : "memory"); asm volatile("ds_read_b64_tr_b16 %0, %1" : "=&v"(t1[ks]) : "v"(ab + RS * (32 * ks + 4)) : "memory"); }
                asm volatile("s_waitcnt lgkmcnt(0)" ::: "memory"); __builtin_amdgcn_sched_barrier(0);
                f32x4 acc = (f32x4){0.f, 0.f, 0.f, 0.f};
#pragma unroll
                for (int ks = 0; ks < 4; ++ks) { const bf16x8_t bfr = (bf16x8_t){t0[ks][0], t0[ks][1], t0[ks][2], t0[ks][3], t1[ks][0], t1[ks][1], t1[ks][2], t1[ks][3]}; acc = __builtin_amdgcn_mfma_f32_16x16x32_bf16(af[ks], bfr, acc, 0, 0, 0); }
                const int ch = 16 * ct + n16;
#pragma unroll
                for (int e = 0; e < 4; ++e) { const size_t row = (size_t)(rb + 16 * F.wave + 4 * kq + e);
                    const float gu = __uint_as_float(guv[c8][e] << 16); CAT[row * DM + 1536 + ch] = (bf16)f2bf(gelu_tanh(gu) * (acc[e] + bsv[e])); }
            }
        }
        asm volatile("s_waitcnt lgkmcnt(0)\n\ts_barrier" ::: "memory");
    }
}


namespace pg8 {
__device__ __forceinline__ void rstd_table(const float* ssq, int pm, PG8_LAS float* rt, int tid) {
    if (tid < 256) { const f32x4* p = (const f32x4*)(ssq + (size_t)(pm * BM + tid) * 32); f32x4 s = p[0];
#pragma unroll
        for (int j = 1; j < 8; ++j) s = s + p[j];
        rt[tid] = __builtin_amdgcn_rsqf(((s[0] + s[1]) + (s[2] + s[3])) * (1.f / 2048.f) + 1e-6f); }
    asm volatile("s_waitcnt lgkmcnt(0)\n\ts_barrier" ::: "memory");
}
struct EpiIn {
    static constexpr bool PERM = true, AFTER_DRAIN = false, PERM_A = false;
    bf16_t* Z; const float* rstd_; const float* shw; const PG8_LAS float* rtab;
    __device__ __forceinline__ void operator()(const f32x4 (&acc)[2][2][4][2], const Unit& u, int wr, int wc, int fr, int fq) const {
        const bool lat = u.pm < 64, ropeq = u.pn < 4, ropek = u.pn == 4; const int mrow = lat ? (u.pm >> 4) : 4;
        const int col0 = u.pn * BM + wc * 32 + 8 * fq;
        f32x4 sh[2][2];
#pragma unroll
        for (int bj = 0; bj < 2; ++bj)
#pragma unroll
            for (int n = 0; n < 2; ++n) sh[bj][n] = *(const f32x4*)(shw + (size_t)mrow * (2816 + 11264) + col0 + bj * HALF + 4 * n);
        const float C2 = 0.125f * 1.4426950408889634f;
        if (!(lat && (ropeq || ropek))) {
            const float qs = ropeq ? C2 : 1.f;
#pragma unroll
            for (int ai = 0; ai < 2; ++ai)
#pragma unroll
                for (int m = 0; m < 4; ++m) { const size_t row = (size_t)u.pm * BM + ai * HALF + wr * 64 + m * 16 + fr; const float rq = rstd_[row] * qs;
#pragma unroll
                    for (int bj = 0; bj < 2; ++bj) { const f32x4 v0 = acc[ai][bj][m][0] * rq + sh[bj][0] * qs, v1 = acc[ai][bj][m][1] * rq + sh[bj][1] * qs;
                        u32x4 w; w.x = cvt_pk_bf16(v0[0], v0[1]); w.y = cvt_pk_bf16(v0[2], v0[3]); w.z = cvt_pk_bf16(v1[0], v1[1]); w.w = cvt_pk_bf16(v1[2], v1[3]);
                        *(u32x4*)(Z + row * 2816 + col0 + bj * HALF) = w; } }
        } else {
#pragma unroll
        for (int ai = 0; ai < 2; ++ai)
#pragma unroll
            for (int m = 0; m < 4; ++m) { const int r = ai * HALF + wr * 64 + m * 16 + fr; const size_t row = (size_t)u.pm * BM + r; const float rstd = rstd_[row];
                const int t = (int)(row & 4095); const PG8_LAS float* tp = rtab + ((wc & 1) ? (t & 63) : (t >> 6)) * 36 + (wc & 1) * 16 + 8 * (fq & 1) + 4 * (fq >> 1);
                const f32x4 cc = *(const PG8_LAS f32x4*)tp, ss = *(const PG8_LAS f32x4*)(tp + 64 * 36);
#pragma unroll
                for (int bj = 0; bj < 2; ++bj) { f32x4 v0 = acc[ai][bj][m][0] * rstd + sh[bj][0], v1 = acc[ai][bj][m][1] * rstd + sh[bj][1];
                    if (ropeq || bj == 0) {
#pragma unroll
                        for (int i = 0; i < 4; ++i) { auto a = __builtin_amdgcn_permlane32_swap(__float_as_uint(v0[i]), __float_as_uint(v1[i]), false, false);
                            const float x1 = __uint_as_float(a[0]), x2 = __uint_as_float(a[1]); const float o1 = x1 * cc[i] - x2 * ss[i], o2 = x1 * ss[i] + x2 * cc[i];
                            auto b = __builtin_amdgcn_permlane32_swap(__float_as_uint(o1), __float_as_uint(o2), false, false); v0[i] = __uint_as_float(b[0]); v1[i] = __uint_as_float(b[1]); } }
                    if (ropeq) { v0 = v0 * C2; v1 = v1 * C2; }
                    u32x4 w; w.x = cvt_pk_bf16(v0[0], v0[1]); w.y = cvt_pk_bf16(v0[2], v0[3]); w.z = cvt_pk_bf16(v1[0], v1[1]); w.w = cvt_pk_bf16(v1[2], v1[3]);
                    *(u32x4*)(Z + row * 2816 + col0 + bj * HALF) = w; } }
        }
    }
};
struct EpiUpConv {
    static constexpr bool PERM = false, AFTER_DRAIN = false, PERM_A = true;
    bf16_t* ACT; const float* rstd_; const float* shw; const float* cw; const float* cb; float* EG; float* EV; PG8_LAS float* edg;
    __device__ __forceinline__ void operator()(const f32x4 (&acc)[2][2][4][2], const Unit& u, int wr, int wc, int fr, int fq) const {
        const int mrow = u.pm < 64 ? (u.pm >> 4) : 4; const int colg = u.pn * BM + wc * 32 + 4 * fq, cl = wc * 32 + 4 * fq, cg0 = u.pn * HALF + cl;
        f32x4 shg[2], shv[2], w0[2], w1[2], w2[2], bb[2];
#pragma unroll
        for (int n = 0; n < 2; ++n) { shg[n] = *(const f32x4*)(shw + (size_t)mrow * (2816 + 11264) + colg + 16 * n); shv[n] = *(const f32x4*)(shw + (size_t)mrow * (2816 + 11264) + colg + HALF + 16 * n);
            w0[n] = *(const f32x4*)(cw + cg0 + 16 * n); w1[n] = *(const f32x4*)(cw + 5632 + cg0 + 16 * n); w2[n] = *(const f32x4*)(cw + 2 * 5632 + cg0 + 16 * n); bb[n] = *(const f32x4*)(cb + cg0 + 16 * n); }
        f32x4 g[2][4][2], v[2][4][2];
#pragma unroll
        for (int ai = 0; ai < 2; ++ai) { const f32x4 rs4 = *(const f32x4*)(rstd_ + (size_t)u.pm * BM + ai * HALF + wr * 64 + 4 * fr);
#pragma unroll
            for (int m = 0; m < 4; ++m)
#pragma unroll
                for (int n = 0; n < 2; ++n) { g[ai][m][n] = acc[ai][0][m][n] * rs4[m] + shg[n]; v[ai][m][n] = acc[ai][1][m][n] * rs4[m] + shv[n]; } }
#pragma unroll
        for (int ai = 0; ai < 2; ++ai) { const int blk = 2 * ai + wr;
            if (fr == 0 && blk > 0) {
#pragma unroll
                for (int n = 0; n < 2; ++n) *(PG8_LAS f32x4*)(edg + (2 * blk - 1) * 128 + cl + 16 * n) = g[ai][0][n]; }
            if (fr == 15 && blk < 3) {
#pragma unroll
                for (int n = 0; n < 2; ++n) *(PG8_LAS f32x4*)(edg + (2 * blk) * 128 + cl + 16 * n) = g[ai][3][n]; } }
        { float* eg = EG + ((size_t)(u.pm * 44 + u.pn) * 4) * 128 + cl; float* ev = EV + ((size_t)(u.pm * 44 + u.pn) * 2) * 128 + cl;
          if (wr == 0 && fr == 0) {
#pragma unroll
              for (int n = 0; n < 2; ++n) { *(f32x4*)(eg + 16 * n) = g[0][0][n]; *(f32x4*)(eg + 128 + 16 * n) = g[0][1][n]; *(f32x4*)(ev + 16 * n) = v[0][0][n]; } }
          if (wr == 1 && fr == 15) {
#pragma unroll
              for (int n = 0; n < 2; ++n) { *(f32x4*)(eg + 2 * 128 + 16 * n) = g[1][2][n]; *(f32x4*)(eg + 3 * 128 + 16 * n) = g[1][3][n]; *(f32x4*)(ev + 128 + 16 * n) = v[1][3][n]; } } }
        asm volatile("s_waitcnt lgkmcnt(0)\n\ts_barrier" ::: "memory");
#pragma unroll
        for (int ai = 0; ai < 2; ++ai) { const int blk = 2 * ai + wr;
#pragma unroll
            for (int n = 0; n < 2; ++n) { f32x4 top = {0.f, 0.f, 0.f, 0.f}, bot = top;
                if (blk > 0) top = *(const PG8_LAS f32x4*)(edg + (2 * (blk - 1)) * 128 + cl + 16 * n);
                if (blk < 3) bot = *(const PG8_LAS f32x4*)(edg + (2 * (blk + 1) - 1) * 128 + cl + 16 * n);
                f32x4 upv, dnv;
#pragma unroll
                for (int i = 0; i < 4; ++i) { upv[i] = __int_as_float(__builtin_amdgcn_update_dpp(__float_as_int(top[i]), __float_as_int(g[ai][3][n][i]), 0x111, 0xf, 0xf, false));
                                              dnv[i] = __int_as_float(__builtin_amdgcn_update_dpp(__float_as_int(bot[i]), __float_as_int(g[ai][0][n][i]), 0x101, 0xf, 0xf, false)); }
#pragma unroll
                for (int m = 0; m < 4; ++m) { const f32x4 up = m == 0 ? upv : g[ai][m == 0 ? 0 : m - 1][n], dn = m == 3 ? dnv : g[ai][m == 3 ? 3 : m + 1][n]; f32x4 o;
                    const f32x4 pre = __builtin_elementwise_fma(w0[n], up, __builtin_elementwise_fma(w1[n], g[ai][m][n], __builtin_elementwise_fma(w2[n], dn, bb[n])));
                    const f32x4 ea = pre * -1.4426950408889634f, pvv = pre * v[ai][m][n]; f32x4 den;
#pragma unroll
                    for (int i = 0; i < 4; ++i) den[i] = __builtin_amdgcn_exp2f(ea[i]);
                    den = den + 1.f;
#pragma unroll
                    for (int i = 0; i < 4; ++i) den[i] = __builtin_amdgcn_rcpf(den[i]);
                    o = pvv * den;
                    typedef unsigned u32x2_t __attribute__((ext_vector_type(2))); u32x2_t w; w.x = cvt_pk_bf16(o[0], o[1]); w.y = cvt_pk_bf16(o[2], o[3]);
                    *(u32x2_t*)(ACT + (size_t)(u.pm * BM + ai * HALF + wr * 64 + 4 * fr + m) * 5632 + cg0 + 16 * n) = w; } } }
    }
};
struct EpiRes {
    static constexpr bool PERM = false, AFTER_DRAIN = false, PERM_A = false;
    float* X; const float* Xr; const float* Xrc; const float* gate; const float* gsn; bf16_t* An; float* ssq;
    __device__ __forceinline__ void operator()(const f32x4 (&acc)[2][2][4][2], const Unit& u, int wr, int wc, int fr, int fq) const {
        const int row0 = u.pm * BM + wr * 64 + fr, col0 = u.pn * BM + wc * 32 + 4 * fq; const int mrow = u.pm < 64 ? (u.pm >> 4) : 4;
        f32x4 gv[2][2], sv[2][2];
#pragma unroll
        for (int bj = 0; bj < 2; ++bj)
#pragma unroll
            for (int n = 0; n < 2; ++n) { gv[bj][n] = *(const f32x4*)(gate + (size_t)mrow * (6 * 2048) + col0 + bj * HALF + n * 16); sv[bj][n] = gsn ? *(const f32x4*)(gsn + (size_t)mrow * 2048 + col0 + bj * HALF + n * 16) : (f32x4){0.f, 0.f, 0.f, 0.f}; }
#pragma unroll
        for (int ai = 0; ai < 2; ++ai)
#pragma unroll
            for (int mp = 0; mp < 2; ++mp) { f32x4 xin[2][2][2];
#pragma unroll
                for (int mm = 0; mm < 2; ++mm) { const size_t row = (size_t)(row0 + ai * HALF + (2 * mp + mm) * 16); const float* rowr = (u.pm < 64 ? Xr : Xrc) + row * 2048 + col0;
#pragma unroll
                    for (int bj = 0; bj < 2; ++bj)
#pragma unroll
                        for (int n = 0; n < 2; ++n) xin[mm][bj][n] = *(const f32x4*)(rowr + bj * HALF + n * 16); }
#pragma unroll
                for (int mm = 0; mm < 2; ++mm) { const int m = 2 * mp + mm; const size_t row = (size_t)(row0 + ai * HALF + m * 16); float* rowp = X + row * 2048 + col0; float q = 0.f;
#pragma unroll
                    for (int bj = 0; bj < 2; ++bj)
#pragma unroll
                        for (int n = 0; n < 2; ++n) { f32x4* p = (f32x4*)(rowp + bj * HALF + n * 16); const f32x4 x = xin[mm][bj][n] + gv[bj][n] * acc[ai][bj][m][n]; *p = x; q += (x[0] * x[0] + x[1] * x[1]) + (x[2] * x[2] + x[3] * x[3]);
                            if (gsn) { const f32x4 y = x * sv[bj][n]; typedef unsigned u32x2_t __attribute__((ext_vector_type(2))); u32x2_t w; w.x = cvt_pk_bf16(y[0], y[1]); w.y = cvt_pk_bf16(y[2], y[3]); *(u32x2_t*)(An + row * 2048 + col0 + bj * HALF + n * 16) = w; } }
                    if (gsn) { { auto r_ = __builtin_amdgcn_permlane16_swap(__float_as_uint(q), __float_as_uint(q), false, false); q = __uint_as_float(r_[0]) + __uint_as_float(r_[1]); }
                                { auto r_ = __builtin_amdgcn_permlane32_swap(__float_as_uint(q), __float_as_uint(q), false, false); q = __uint_as_float(r_[0]) + __uint_as_float(r_[1]); }
                                if (fq == 0) ssq[row * 32 + u.pn * 4 + wc] = q; } } }
    }
};
struct PieceOrder {
    int c0, G, np, nks, klen_b, uneven;
    __device__ __forceinline__ bool next(int i, Unit& u) const { const int c = c0 + i * G; if (c >= np) return false; const int ks = c % nks, t = c / nks; u.pn = t & 7; u.pm = 64 + (t >> 3); u.aux = ks;
        if (uneven) { u.kb = (11 * ks - (ks & 1)) * 128; u.nt = 10 + 2 * (ks & 1); } else { u.kb = ks * klen_b; u.nt = 0; } return true; }
    __device__ __forceinline__ void a_ready(const Unit&) const {}
    __device__ __forceinline__ void done(const Unit&) const {}
};
struct EpiSlab {
    static constexpr bool PERM = false, AFTER_DRAIN = false, PERM_A = false;
    float* S;
    __device__ __forceinline__ void operator()(const f32x4 (&acc)[2][2][4][2], const Unit& u, int wr, int wc, int fr, int fq) const {
        float* base = S + ((size_t)u.aux * 1024 + (size_t)(u.pm - 64) * BM + wr * 64 + fr) * 2048 + u.pn * BM + wc * 32 + 4 * fq;
#pragma unroll
        for (int ai = 0; ai < 2; ++ai)
#pragma unroll
            for (int m = 0; m < 4; ++m)
#pragma unroll
                for (int bj = 0; bj < 2; ++bj)
#pragma unroll
                    for (int n = 0; n < 2; ++n) *(f32x4*)(base + (size_t)(ai * HALF + m * 16) * 2048 + bj * HALF + n * 16) = acc[ai][bj][m][n];
    }
};
struct EpiNone { static constexpr bool PERM = false, AFTER_DRAIN = false, PERM_A = false; float* sink;
    __device__ __forceinline__ void operator()(const f32x4 (&acc)[2][2][4][2], const Unit& u, int wr, int wc, int fr, int fq) const { f32x4 s = acc[0][0][0][0];
#pragma unroll
        for (int a = 0; a < 2; ++a)
#pragma unroll
            for (int b = 0; b < 2; ++b)
#pragma unroll
                for (int m = 0; m < 4; ++m)
#pragma unroll
                    for (int n = 0; n < 2; ++n) s = s + acc[a][b][m][n];
        if (s[0] + s[1] + s[2] + s[3] == 1.2345e-33f) sink[0] = 1.f; } };
struct EpiGlu {
    static constexpr bool PERM = true, AFTER_DRAIN = false, PERM_A = false;
    const bf16_t* Gs; const float* bias; bf16_t* O; int ldo, ooff;
    __device__ __forceinline__ void operator()(const f32x4 (&acc)[2][2][4][2], const Unit& u, int wr, int wc, int fr, int fq) const {
        const int row0 = u.pm * BM + wr * 64 + fr, col0 = u.pn * BM + wc * 32 + 8 * fq;
        f32x4 bs[2][2];
#pragma unroll
        for (int bj = 0; bj < 2; ++bj) { bs[bj][0] = *(const f32x4*)(bias + col0 + bj * HALF); bs[bj][1] = *(const f32x4*)(bias + col0 + bj * HALF + 4); }
#pragma unroll
        for (int ai = 0; ai < 2; ++ai) { u32x4 gw[4][2];
#pragma unroll
            for (int m = 0; m < 4; ++m)
#pragma unroll
                for (int bj = 0; bj < 2; ++bj) gw[m][bj] = *(const u32x4*)(Gs + (size_t)(row0 + ai * HALF + m * 16) * 512 + col0 + bj * HALF);
#pragma unroll
            for (int m = 0; m < 4; ++m) { const size_t r = (size_t)(row0 + ai * HALF + m * 16);
#pragma unroll
                for (int bj = 0; bj < 2; ++bj) { const int c = col0 + bj * HALF; const f32x4 v0 = acc[ai][bj][m][0] + bs[bj][0], v1 = acc[ai][bj][m][1] + bs[bj][1]; const u32x4 g = gw[m][bj];
                    u32x4 w;
                    w.x = cvt_pk_bf16(__uint_as_float(g.x << 16) * __builtin_amdgcn_rcpf(1.f + __builtin_amdgcn_exp2f(v0[0] * -1.4426950408889634f)), __uint_as_float(g.x & 0xffff0000u) * __builtin_amdgcn_rcpf(1.f + __builtin_amdgcn_exp2f(v0[1] * -1.4426950408889634f)));
                    w.y = cvt_pk_bf16(__uint_as_float(g.y << 16) * __builtin_amdgcn_rcpf(1.f + __builtin_amdgcn_exp2f(v0[2] * -1.4426950408889634f)), __uint_as_float(g.y & 0xffff0000u) * __builtin_amdgcn_rcpf(1.f + __builtin_amdgcn_exp2f(v0[3] * -1.4426950408889634f)));
                    w.z = cvt_pk_bf16(__uint_as_float(g.z << 16) * __builtin_amdgcn_rcpf(1.f + __builtin_amdgcn_exp2f(v1[0] * -1.4426950408889634f)), __uint_as_float(g.z & 0xffff0000u) * __builtin_amdgcn_rcpf(1.f + __builtin_amdgcn_exp2f(v1[1] * -1.4426950408889634f)));
                    w.w = cvt_pk_bf16(__uint_as_float(g.w << 16) * __builtin_amdgcn_rcpf(1.f + __builtin_amdgcn_exp2f(v1[2] * -1.4426950408889634f)), __uint_as_float(g.w & 0xffff0000u) * __builtin_amdgcn_rcpf(1.f + __builtin_amdgcn_exp2f(v1[3] * -1.4426950408889634f)));
                    *(u32x4*)(O + r * ldo + ooff + c) = w; } } }
    }
};
}

constexpr int NP0 = 3, NPL = 11, NPH = NP0 + NPL * DEPTH + 1;
#ifndef MK_N_LAUNCHES
#define MK_N_LAUNCHES 1
#endif
__global__ void __launch_bounds__(NWAVES * 64, 2) mk_fwd(Args args) {
    extern __shared__ __attribute__((aligned(16))) unsigned char lds[];
    Frame F;
    F.lds = (LAS unsigned char*)lds; const int wave0 = __builtin_amdgcn_readfirstlane((int)threadIdx.x >> 6);
    F.tid = threadIdx.x; F.lane = F.tid & 63; F.wave = wave0; F.G = gridDim.x; F.bid = blockIdx.x; F.gw = 0; F.NGW = 0; F.gws = 0; F.gt = 0; F.NGT = 0;
    volatile LAS unsigned* MISC = (volatile LAS unsigned*)(F.lds + MISC_OFF);
    for (int u = F.tid; u < (LDS_BYTES - LDSCTL_OFF) / 4; u += NWAVES * 64) ((LAS unsigned*)(F.lds + LDSCTL_OFF))[u] = 0u;
    __syncthreads();
    const int lo = args.ph_lo, hi = args.ph_hi;
    unsigned* barw = (unsigned*)(args.ws + WS_CTL) + CW_BAR;
    XcdBarrier bar; bar.bar = barw; bar.x = 0; bar.st = nullptr;
    if (hi - lo > 1) bar = xcd_barrier_post(barw, MISC + 8);
#define IN(k) (lo <= (k) && (k) < hi)
#define FRESH() do { int w_ = wave0, b_ = (int)blockIdx.x, g_ = (int)gridDim.x, t_; asm volatile("" : "+s"(w_), "+s"(b_), "+s"(g_)); asm volatile("v_mbcnt_lo_u32_b32 %0, -1, 0\n\tv_mbcnt_hi_u32_b32 %0, -1, %0" : "=v"(t_)); t_ += w_ * 64; \
    F.wave = w_; F.bid = b_; F.G = g_; F.tid = t_; F.lane = t_ & 63; F.gw = b_ * NWAVES + w_; F.NGW = g_ * NWAVES; F.gws = w_ * g_ + b_; F.gt = b_ * (NWAVES * 64) + t_; F.NGT = g_ * NWAVES * 64; } while (0)
#define SEAM(k) do { if ((k) + 1 < hi) xcd_barrier(bar); } while (0)
#ifndef REP_MASK
#define REP_MASK 0
#endif
#define REP(kind) for (int rep_##kind = 0; rep_##kind < ((REP_MASK >> (kind)) & 1) + 1; ++rep_##kind)
#define PB() Args pa = args; { size_t z_ = 0; asm volatile("" : "+s"(z_)); pa.ws = args.ws + z_; } unsigned char* const ws = pa.ws
    if (IN(0)) REP(8) { PB(); FRESH(); p0a(F, pa); FRESH(); p0a_conv(F, pa); SEAM(0); }
    if (IN(1)) REP(9) { PB(); FRESH(); REP(10) { p0b_conv(F, pa); FRESH(); p0b(F, pa); FRESH(); } REP(11) { s5_tables(F, pa); } SEAM(1); }
    if (IN(2)) REP(12) { PB(); FRESH(); p0c(F, pa); SEAM(2); }
#pragma unroll 1
    for (int l = 0; l < DEPTH; ++l) {
        const int pb = NP0 + NPL * l; const bool last = l == DEPTH - 1;
        if (IN(pb + 0)) REP(1) { PB(); FRESH();
            pg8::Gemm g{(const bf16*)(ws + WS_A), w_in_t(ws, l), MA, N_IN, DM, DM}; pg8::StaticOrder S; S.init(MA, N_IN, F.G, F.bid);
            { const float* RC = (const float*)(ws + WS_ROPE); LAS float* tab = (LAS float*)(F.lds + ROPE_OFF);
              for (int i = F.tid; i < 2 * 64 * 32; i += NWAVES * 64) { const int cs = i >> 11, p = (i >> 5) & 63, j = i & 31; tab[cs * 64 * ROPE_STRIDE + p * ROPE_STRIDE + j] = RC[cs * SEQ * 32 + (j < 16 ? p * 64 : p) * 32 + j]; }
              WG_BAR(); }
            pg8::EpiIn E{(bf16*)(ws + WS_Z), (const float*)(ws + WS_RSTD), (const float*)(ws + WS_SHW) + (size_t)l * 5 * NSH, (const LAS float*)(F.lds + ROPE_OFF)};
            pg8::gemm_phase<pg8::EpiIn, pg8::StaticOrder, true, true>(F.lds + RING_OFF, g, S, E, F.wave);
            SEAM(pb + 0); }
        if (IN(pb + 1)) REP(2) { PB(); FRESH(); s5_chunk_states(F, pa, l); attn_phase(F, pa, l, !last); SEAM(pb + 1); }
        if (IN(pb + 2)) REP(3) { PB(); FRESH(); s5_carries(F, pa, l); gmlp_phase(F, pa, l, !last); SEAM(pb + 2); }
        if (IN(pb + 3)) REP(4) { PB(); FRESH(); s5_outputs(F, pa, l, !last); SEAM(pb + 3); }
        if (IN(pb + 4)) REP(5) { PB(); FRESH();
            pg8::Gemm g{(const bf16*)(ws + WS_GS), w_glu_t(ws, l), MA, SSM_W, SSM_W, SSM_W}; pg8::StaticOrder S; S.init(MA, SSM_W, F.G, F.bid);
            pg8::EpiGlu E{(const bf16*)(ws + WS_GS), pa.in[I_BGLU] + l * SSM_W, (bf16*)(ws + WS_CAT), DM, 1024};
            pg8::gemm_phase<pg8::EpiGlu, pg8::StaticOrder, true, true>(F.lds + RING_OFF, g, S, E, F.wave);
            SEAM(pb + 4); }
        if (IN(pb + 5)) { PB(); FRESH();
            { pg8::Gemm g{(const bf16*)(ws + WS_CAT), w_out_t(ws, l), ML, DM, DM, DM}; pg8::StaticOrder S; S.init(ML, DM, F.G, F.bid);
              pg8::EpiRes E{(float*)(ws + WS_XS), l == 0 ? pa.in[I_X] : (const float*)(ws + WS_XS), (const float*)(ws + WS_XS), (const float*)(ws + WS_MOD) + (size_t)l * 5 * NMOD + 2 * DM, (const float*)(ws + WS_GSV) + (size_t)(l * 2 + 1) * 5 * DM, (bf16*)(ws + WS_A), (float*)(ws + WS_SSQ) + (size_t)MA * 32};
              pg8::gemm_phase<pg8::EpiRes, pg8::StaticOrder, true, true>(F.lds + RING_OFF, g, S, E, F.wave); }
            if (!last) { FRESH();
              pg8::Gemm g{(const bf16*)(ws + WS_CAT), w_out_t(ws, l), MA, DM, 256, DM}; pg8::PieceOrder S{F.bid, F.G, 256, 8, 512, 0};
              pg8::EpiSlab E{(float*)(ws + WS_SLAB)};
              pg8::gemm_phase<pg8::EpiSlab, pg8::PieceOrder, true, true>(F.lds + RING_OFF, g, S, E, F.wave); }
            SEAM(pb + 5); }
        if (IN(pb + 6)) { PB(); FRESH(); lat_rstd(F, pa, 0); if (!last) ctx_reduce(F, pa, l, 0); SEAM(pb + 6); }
        if (IN(pb + 7)) REP(6) { PB(); FRESH();
            pg8::Gemm g{(const bf16*)(ws + WS_A), w_up_t(ws, l), MA, NUP, DM, DM}; pg8::StaticOrder S; S.init(last ? ML : MA, NUP, F.G, F.bid);
            pg8::EpiUpConv E{(bf16*)(ws + WS_ACT), (const float*)(ws + WS_RSTD) + MA, (const float*)(ws + WS_SHW) + (size_t)l * 5 * NSH + N_IN, pa.in[I_CW] + (size_t)l * 3 * DFF, pa.in[I_CB] + (size_t)l * DFF,
                                (float*)(ws + WS_EG), (float*)(ws + WS_EV), (LAS float*)(F.lds + EDG_OFF)};
            pg8::gemm_phase<pg8::EpiUpConv, pg8::StaticOrder, true, true>(F.lds + RING_OFF, g, S, E, F.wave);
            SEAM(pb + 7); }
        if (IN(pb + 7) && ((REP_MASK >> 13) & 1)) { PB(); FRESH();
            pg8::Gemm g{(const bf16*)(ws + WS_A), w_up_t(ws, l), MA, NUP, DM, DM}; pg8::StaticOrder S; S.init(MA, NUP, F.G, F.bid);
            pg8::EpiNone E{(float*)(ws + WS_EG)};
            pg8::gemm_phase<pg8::EpiNone, pg8::StaticOrder, true, true>(F.lds + RING_OFF, g, S, E, F.wave);
            xcd_barrier(bar); }
        if (IN(pb + 8)) REP(7) { PB(); FRESH(); conv_fixup(F, pa, l); SEAM(pb + 8); }
        if (IN(pb + 9)) { PB(); FRESH();
            { pg8::Gemm g{(const bf16*)(ws + WS_ACT), w_dn_t(ws, l), ML, DM, DFF, DFF}; pg8::StaticOrder S; S.init(ML, DM, F.G, F.bid);
              pg8::EpiRes E{(float*)(ws + WS_XS), (const float*)(ws + WS_XS), (const float*)(ws + WS_XS), (const float*)(ws + WS_MOD) + (size_t)l * 5 * NMOD + 5 * DM, last ? nullptr : (const float*)(ws + WS_GSV) + (size_t)((l + 1) * 2) * 5 * DM, (bf16*)(ws + WS_A), (float*)(ws + WS_SSQ)};
              pg8::gemm_phase<pg8::EpiRes, pg8::StaticOrder, true, true>(F.lds + RING_OFF, g, S, E, F.wave); }
            if (!last) { FRESH();
              pg8::Gemm g{(const bf16*)(ws + WS_ACT), w_dn_t(ws, l), MA, DM, 640, DFF}; pg8::PieceOrder S{F.bid, F.G, 256, 8, 0, 1};
              pg8::EpiSlab E{(float*)(ws + WS_SLAB)};
              pg8::gemm_phase<pg8::EpiSlab, pg8::PieceOrder, true, true>(F.lds + RING_OFF, g, S, E, F.wave); }
            SEAM(pb + 9); }
        if (IN(pb + 9) && ((REP_MASK >> 14) & 1)) { PB(); FRESH();
            pg8::Gemm g{(const bf16*)(ws + WS_ACT), w_dn_t(ws, l), ML, DM, DFF, DFF}; pg8::StaticOrder S; S.init(ML, DM, F.G, F.bid);
            pg8::EpiNone E{(float*)(ws + WS_EG)};
            pg8::gemm_phase<pg8::EpiNone, pg8::StaticOrder, true, true>(F.lds + RING_OFF, g, S, E, F.wave);
            xcd_barrier(bar); }
        if (IN(pb + 10) && !last) { PB(); FRESH(); lat_rstd(F, pa, 1); ctx_reduce(F, pa, l, 1); SEAM(pb + 10); }
    }
    if (IN(NPH - 1)) { PB(); FRESH(); final_norm(F, pa); }
#undef IN
#undef SEAM
}

extern "C" void kernel_launch(void* const* d_in, const int* in_sizes, int n_in, void* d_out, int out_size, void* d_ws, size_t ws_size, hipStream_t stream) {
    static int grid = 0;
    if (grid == 0) {
        if (n_in != N_INPUTS || in_sizes[0] != ML * DM || out_size != ML * DM || ws_size < WS_END2) {
            fprintf(stderr, "kernel_launch: unexpected shapes (n_in %d, in0 %d, out %d, ws %zu need %zu); nothing launched\n", n_in, n_in > 0 ? in_sizes[0] : -1, out_size, ws_size, (size_t)WS_END2); grid = -1; return; }
        int dev = 0, cus = 0, per_cu = 0;
        if (hipGetDevice(&dev) != hipSuccess || hipDeviceGetAttribute(&cus, hipDeviceAttributeMultiprocessorCount, dev) != hipSuccess) { fprintf(stderr, "kernel_launch: device query failed\n"); grid = -1; return; }
        if (hipFuncSetAttribute((const void*)mk_fwd, hipFuncAttributeMaxDynamicSharedMemorySize, LDS_BYTES) != hipSuccess) { fprintf(stderr, "kernel_launch: hipFuncSetAttribute failed\n"); grid = -1; return; }
        if (hipOccupancyMaxActiveBlocksPerMultiprocessor(&per_cu, (const void*)mk_fwd, NWAVES * 64, LDS_BYTES) != hipSuccess || per_cu < 1) { fprintf(stderr, "kernel_launch: occupancy query says %d blocks per CU\n", per_cu); }
        (void)hipGetLastError();
        grid = cus;
    }
    if (grid < 0) return;
    if (hipMemsetAsync((char*)d_ws + WS_CTL, 0, CTL_ZERO_BYTES, stream) != hipSuccess) { fprintf(stderr, "kernel_launch: memset failed\n"); return; }
    Args a{};
    for (int i = 0; i < N_INPUTS; ++i) a.in[i] = (const float*)d_in[i];
    a.out = (float*)d_out; a.ws = (unsigned char*)d_ws;
    if (MK_N_LAUNCHES == 1) { a.ph_lo = 0; a.ph_hi = NPH; hipLaunchKernelGGL(mk_fwd, dim3(grid), dim3(NWAVES * 64), LDS_BYTES, stream, a); }
    else { for (int p = 0; p < NPH; ++p) { a.ph_lo = p; a.ph_hi = p + 1; hipLaunchKernelGGL(mk_fwd, dim3(grid), dim3(NWAVES * 64), LDS_BYTES, stream, a); } }
    const hipError_t le = hipPeekAtLastError();
    if (le != hipSuccess) fprintf(stderr, "kernel_launch: launch failed: %s\n", hipGetErrorName(le));
}
```

```cpp
#include <hip/hip_runtime.h>
#include <cstdio>
#include <cstdint>
namespace pg8 {
#define PG8_LAS __attribute__((address_space(3)))
typedef unsigned short bf16_t;
typedef short bf16x8 __attribute__((ext_vector_type(8)));
typedef float f32x4 __attribute__((ext_vector_type(4)));
typedef unsigned u32x4 __attribute__((ext_vector_type(4)));
constexpr int BM = 256, BK = 64, HALF = 128, HTB = HALF * BK * 2  , STAGE_BYTES = 8 * HTB, NXCD = 8, WGM = 4;

__host__ __device__ __forceinline__ int lds_byte(int r, int c) { const int st = (r >> 4) * 2 + (c >> 5), rr = r & 15, cc = c & 31, ob = rr * 64 + cc * 2; return st * 1024 + (ob ^ (((ob >> 9) & 1) << 5)); }
__host__ __device__ __forceinline__ void stage_rc(int b, int& R, int& C) { const int st = b / 1024, sb = b % 1024, swz = sb ^ (((sb >> 9) & 1) << 5); R = (st >> 1) * 16 + swz / 64; C = (st & 1) * 32 + (swz % 64) / 2; }
__host__ __device__ __forceinline__ int perm32(int rho) { const int n = rho >> 4, i = rho & 15; return 8 * (i >> 2) + 4 * n + (i & 3); }

struct Unit { int pm, pn, kb, nt, aux; };
struct Gemm { const bf16_t* A; const bf16_t* Bt; int M, N, K, ld; int apair = 0; };

struct StaticOrder {
    int nM, nN, nwg, G, c;
    __host__ __device__ void init(int M, int N, int G_, int c_) { nM = M / BM; nN = N / BM; nwg = nM * nN; G = G_; c = c_; }
    __host__ __device__ bool next(int i, Unit& u) const {
        const long L = (long)i * G + c; if (L >= nwg) return false;
        int wgid = (int)L; { const int q = nwg / NXCD, r = nwg % NXCD, xcd = wgid % NXCD, off = wgid / NXCD; wgid = (xcd < r ? xcd * (q + 1) : r * (q + 1) + (xcd - r) * q) + off; }
        const int nig = WGM * nN, gid = wgid / nig, fm = gid * WGM, gsz = (nM - fm) < WGM ? (nM - fm) : WGM;
        u.pm = fm + ((wgid % nig) % gsz); u.pn = (wgid % nig) / gsz; u.kb = 0; u.nt = 0; u.aux = 0; return true;
    }
    __device__ __forceinline__ void a_ready(const Unit&) const {}
    __device__ __forceinline__ void done(const Unit&) const {}
};

__device__ __forceinline__ unsigned cvt_pk_bf16(float lo, float hi) { unsigned r; asm volatile("v_cvt_pk_bf16_f32 %0, %1, %2" : "=v"(r) : "v"(lo), "v"(hi)); return r; }
typedef float f32x2 __attribute__((ext_vector_type(2)));
template <int ACT  > struct EpiBf16 {
    static constexpr bool PERM = true, AFTER_DRAIN = false, PERM_A = false, MFMA32 = false; static_assert(ACT == 0 || ACT == 1, "EpiBf16: ACT is 0 (none) or 1 (gelu_pk)");
    bf16_t* O; int ldc; const float* bias; int split_cols; size_t split_stride; float scale0;
    __device__ __forceinline__ void operator()(const f32x4 (&acc)[2][2][4][2], const Unit& u, int wr, int wc, int fr, int fq) const {
        const int row0 = u.pm * BM + wr * 64 + fr; int colt = u.pn * BM; bf16_t* base = O;
        float sc = 1.f; if (split_cols) { const int t = colt / split_cols; base += (size_t)t * split_stride; colt -= t * split_cols; if (t == 0) sc = scale0; }
        const int col0 = colt + wc * 32 + 8 * fq, bcol0 = u.pn * BM + wc * 32 + 8 * fq;
        f32x4 bv[2][2];
#pragma unroll
        for (int bj = 0; bj < 2; ++bj)
#pragma unroll
            for (int n = 0; n < 2; ++n) bv[bj][n] = bias ? *(const f32x4*)(bias + bcol0 + bj * HALF + 4 * n) : (f32x4){0.f, 0.f, 0.f, 0.f};
#pragma unroll
        for (int ai = 0; ai < 2; ++ai)
#pragma unroll
            for (int m = 0; m < 4; ++m) { bf16_t* rowp = base + (size_t)(row0 + ai * HALF + m * 16) * ldc + col0;
#pragma unroll
                for (int bj = 0; bj < 2; ++bj) { f32x4 v0 = acc[ai][bj][m][0] + bv[bj][0], v1 = acc[ai][bj][m][1] + bv[bj][1];
                                        v0 = v0 * sc; v1 = v1 * sc; u32x4 w; w.x = cvt_pk_bf16(v0[0], v0[1]); w.y = cvt_pk_bf16(v0[2], v0[3]); w.z = cvt_pk_bf16(v1[0], v1[1]); w.w = cvt_pk_bf16(v1[2], v1[3]);
                    *(u32x4*)(rowp + bj * HALF) = w; } }
    }
};
template <class Epi, class Sched, bool ALIGN_EPI = false, bool SP2 = false>
__device__ __forceinline__ void gemm_phase(PG8_LAS unsigned char* lds, const Gemm g, const Sched& S, const Epi& E, const int wave_id) {
    int tid_; asm volatile("v_mbcnt_lo_u32_b32 %0, -1, 0\n\tv_mbcnt_hi_u32_b32 %0, -1, %0" : "=v"(tid_)); tid_ += wave_id * 64;
    const int tid = tid_, wid = __builtin_amdgcn_readfirstlane(tid >> 6), lane = tid & 63, wr = wid >> 2, wc = wid & 3, fr = lane & 15, fq = lane >> 4;
    const int K = g.ld, nt0 = g.K / BK;
    unsigned voffA[2], voffB[2];
#pragma unroll
    for (int i = 0; i < 2; ++i) { int R, C; stage_rc(tid * 16 + i * 8192, R, C); const int Rb = Epi::PERM ? ((R & ~31) + perm32(R & 31)) : R;
        const int Ra = Epi::PERM_A ? ((R & ~63) + 4 * (R & 15) + ((R >> 4) & 3)) : R;
        voffA[i] = g.apair ? (unsigned)((Ra >> 1) * (4 * K) + (Ra & 1) * 64 + (C >> 5) * 128 + (C & 31) * 2) : (unsigned)(Ra * K + C) * 2u; voffB[i] = (unsigned)(Rb * K + C) * 2u; }
    const size_t kstep = (size_t)(BK * 2);
    const size_t kstepA = g.apair ? 2 * kstep : kstep; const int kbsA = g.apair ? 2 : 1;
    const size_t hstep = (size_t)HALF * K * 2;
    const size_t tstep = 2 * hstep;
    const unsigned ldsw = (unsigned)wid * 1024u;
    const int aoff = lds_byte(wr * 64 + fr, fq * 8), boff = lds_byte(wc * 32 + fr, fq * 8);
#define PG8_SA(b, h) (((b) * 2 + (h)) * HTB)
#define PG8_SB(b, h) ((4 + (b) * 2 + (h)) * HTB)
#define PG8_STAGE(bufoff, gbase, voff) do { _Pragma("unroll") for (int _i = 0; _i < 2; ++_i) \
        __builtin_amdgcn_global_load_lds((const unsigned*)((const char*)(gbase) + (voff)[_i]), (PG8_LAS unsigned*)(lds + (bufoff) + ldsw + _i * 8192), 16, 0, 0); } while (0)
#define PG8_LDA(dst, b, h) do { _Pragma("unroll") for (int m = 0; m < 4; ++m) _Pragma("unroll") for (int k = 0; k < 2; ++k) dst[m][k] = *(const PG8_LAS bf16x8*)(lds + PG8_SA(b, h) + aoff + m * 2048 + k * 1024); } while (0)
#define PG8_LDB(dst, b, h) do { _Pragma("unroll") for (int n = 0; n < 2; ++n) _Pragma("unroll") for (int k = 0; k < 2; ++k) dst[n][k] = *(const PG8_LAS bf16x8*)(lds + PG8_SB(b, h) + boff + n * 2048 + k * 1024); } while (0)
#define PG8_MMA(ai, bj, At, Bt) do { __builtin_amdgcn_s_setprio(1); _Pragma("unroll") for (int m = 0; m < 4; ++m) _Pragma("unroll") for (int n = 0; n < 2; ++n) _Pragma("unroll") for (int k = 0; k < 2; ++k) \
        acc[ai][bj][m][n] = __builtin_amdgcn_mfma_f32_16x16x32_bf16(Bt[n][k], At[m][k], acc[ai][bj][m][n], 0, 0, 0); __builtin_amdgcn_s_setprio(0); } while (0)
#define PG8_WAIT_V(n) asm volatile("s_waitcnt vmcnt(" #n ")" ::: "memory")
#define PG8_WAIT_L(n) asm volatile("s_waitcnt lgkmcnt(" #n ")" ::: "memory")
#define PG8_BAR __builtin_amdgcn_s_barrier()
#define PG8_SCHED __builtin_amdgcn_sched_barrier(0)
    Unit cur, nxt; int ui = 0;
    if (!S.next(0, cur)) return;
    f32x4 acc[2][2][4][2];
#pragma unroll
    for (int a = 0; a < 2; ++a)
#pragma unroll
        for (int b = 0; b < 2; ++b)
#pragma unroll
            for (int m = 0; m < 4; ++m)
#pragma unroll
                for (int n = 0; n < 2; ++n) acc[a][b][m][n] = (f32x4){0.f, 0.f, 0.f, 0.f};
    bf16x8 At[4][2], B0[2][2], B1[2][2];
    const char* cA = (const char*)g.A + (size_t)cur.pm * tstep + (size_t)cur.kb * kbsA; const char* cB = (const char*)g.Bt + (size_t)cur.pn * tstep + cur.kb;
    S.a_ready(cur);
    if constexpr (SP2) {
        PG8_STAGE(PG8_SB(0, 0), cB, voffB); PG8_STAGE(PG8_SB(0, 1), cB + hstep, voffB); PG8_STAGE(PG8_SA(0, 0), cA, voffA); PG8_STAGE(PG8_SA(0, 1), cA + hstep, voffA);
        if (wr == 1) PG8_BAR;
        PG8_WAIT_V(2); PG8_BAR;
        PG8_STAGE(PG8_SB(1, 0), cB + kstep, voffB); PG8_STAGE(PG8_SA(1, 0), cA + kstepA, voffA); PG8_STAGE(PG8_SB(1, 1), cB + hstep + kstep, voffB);
        PG8_WAIT_V(6); PG8_BAR;
    } else {
        PG8_STAGE(PG8_SB(0, 0), cB, voffB); PG8_STAGE(PG8_SA(0, 0), cA, voffA); PG8_STAGE(PG8_SB(0, 1), cB + hstep, voffB); PG8_STAGE(PG8_SA(0, 1), cA + hstep, voffA);
        if (wr == 1) PG8_BAR;
        PG8_WAIT_V(4); PG8_BAR;
        PG8_STAGE(PG8_SB(1, 0), cB + kstep, voffB); PG8_STAGE(PG8_SA(1, 0), cA + kstepA, voffA); PG8_STAGE(PG8_SB(1, 1), cB + hstep + kstep, voffB);
        PG8_WAIT_V(6); PG8_BAR;
    }
    for (;;) {
        const bool has_next = S.next(ui + 1, nxt); const int nt = cur.nt ? cur.nt : nt0;
        const char* nA = has_next ? (const char*)g.A + (size_t)nxt.pm * tstep + (size_t)nxt.kb * kbsA : cA; const char* nB = has_next ? (const char*)g.Bt + (size_t)nxt.pn * tstep + nxt.kb : cB;
        for (int t = 0; t < nt; t += 2) {
            const bool last = (t == nt - 2);
            const char* a1 = cA + (size_t)(t + 1) * kstepA;
            const char* a2 = last ? nA : cA + (size_t)(t + 2) * kstepA; const char* b2 = last ? nB : cB + (size_t)(t + 2) * kstep;
            const char* a3 = a2 + kstepA; const char* b3 = b2 + kstep;
            if (last && has_next) S.a_ready(nxt);
            if constexpr (SP2) {
            PG8_LDB(B0, 0, 0); PG8_LDB(B1, 0, 1); PG8_SCHED; PG8_LDA(At, 0, 0); PG8_STAGE(PG8_SA(1, 1), a1 + hstep, voffA);
            PG8_WAIT_V(8); PG8_WAIT_L(0); PG8_BAR; PG8_MMA(0, 0, At, B0); PG8_MMA(0, 1, At, B1); PG8_BAR; PG8_SCHED;
            PG8_LDA(At, 0, 1); PG8_STAGE(PG8_SB(0, 0), b2, voffB); PG8_STAGE(PG8_SB(0, 1), b2 + hstep, voffB); PG8_STAGE(PG8_SA(0, 0), a2, voffA);
            PG8_WAIT_V(8); PG8_WAIT_L(0); PG8_BAR; PG8_MMA(1, 0, At, B0); PG8_MMA(1, 1, At, B1); PG8_BAR; PG8_SCHED;
            PG8_LDB(B0, 1, 0); PG8_LDB(B1, 1, 1); PG8_SCHED; PG8_LDA(At, 1, 0); PG8_STAGE(PG8_SA(0, 1), a2 + hstep, voffA);
            PG8_WAIT_V(8); PG8_WAIT_L(0); PG8_BAR; PG8_MMA(0, 0, At, B0); PG8_MMA(0, 1, At, B1); PG8_BAR; PG8_SCHED;
            PG8_LDA(At, 1, 1); PG8_STAGE(PG8_SB(1, 0), b3, voffB); PG8_STAGE(PG8_SB(1, 1), b3 + hstep, voffB); PG8_STAGE(PG8_SA(1, 0), a3, voffA);
            PG8_WAIT_V(8); PG8_WAIT_L(0); PG8_BAR; PG8_MMA(1, 0, At, B0); PG8_MMA(1, 1, At, B1); PG8_BAR; PG8_SCHED;
            } else {
            PG8_LDB(B0, 0, 0); PG8_SCHED; PG8_LDA(At, 0, 0); PG8_STAGE(PG8_SA(1, 1), a1 + hstep, voffA);
            PG8_WAIT_L(8); PG8_BAR; PG8_WAIT_L(0); PG8_MMA(0, 0, At, B0); PG8_BAR; PG8_SCHED;
            PG8_LDB(B1, 0, 1); PG8_STAGE(PG8_SB(0, 0), b2, voffB);
            PG8_BAR; PG8_WAIT_L(0); PG8_MMA(0, 1, At, B1); PG8_BAR;
            PG8_LDA(At, 0, 1); PG8_STAGE(PG8_SA(0, 0), a2, voffA);
            PG8_BAR; PG8_WAIT_L(0); PG8_MMA(1, 0, At, B0); PG8_BAR; PG8_SCHED;
            PG8_STAGE(PG8_SB(0, 1), b2 + hstep, voffB);
            PG8_WAIT_V(6); PG8_BAR; PG8_MMA(1, 1, At, B1); PG8_BAR;
            PG8_LDB(B0, 1, 0); PG8_SCHED; PG8_LDA(At, 1, 0); PG8_STAGE(PG8_SA(0, 1), a2 + hstep, voffA);
            PG8_WAIT_L(8); PG8_BAR; PG8_WAIT_L(0); PG8_MMA(0, 0, At, B0); PG8_BAR; PG8_SCHED;
            PG8_LDB(B1, 1, 1); PG8_STAGE(PG8_SB(1, 0), b3, voffB);
            PG8_BAR; PG8_WAIT_L(0); PG8_MMA(0, 1, At, B1); PG8_BAR;
            PG8_LDA(At, 1, 1); PG8_STAGE(PG8_SA(1, 0), a3, voffA);
            PG8_BAR; PG8_WAIT_L(0); PG8_MMA(1, 0, At, B0); PG8_BAR; PG8_SCHED;
            PG8_STAGE(PG8_SB(1, 1), b3 + hstep, voffB);
            PG8_WAIT_V(6); PG8_BAR; PG8_MMA(1, 1, At, B1); PG8_BAR;
            }
        }
        if constexpr (ALIGN_EPI) { if (wr == 0) PG8_BAR; }
        if constexpr (!Epi::AFTER_DRAIN) { E(acc, cur, wr, wc, fr, fq); S.done(cur); }
        if (!has_next) break;
#pragma unroll
        for (int a = 0; a < 2; ++a)
#pragma unroll
            for (int b = 0; b < 2; ++b)
#pragma unroll
                for (int m = 0; m < 4; ++m)
#pragma unroll
                    for (int n = 0; n < 2; ++n) acc[a][b][m][n] = (f32x4){0.f, 0.f, 0.f, 0.f};
        cur = nxt; cA = nA; cB = nB; ++ui;
        if constexpr (ALIGN_EPI) { if (wr == 1) PG8_BAR; }
    }
    PG8_WAIT_V(0);
    if constexpr (!ALIGN_EPI) { if (wr == 0) PG8_BAR; }
    PG8_BAR;
    if constexpr (Epi::AFTER_DRAIN) { E.fused(acc, cur, wr, wc, fr, fq, lds, wid, lane); S.done(cur); }
#undef PG8_SA
#undef PG8_SB
#undef PG8_STAGE
#undef PG8_LDA
#undef PG8_LDB
#undef PG8_MMA
#undef PG8_WAIT_V
#undef PG8_WAIT_L
#undef PG8_BAR
#undef PG8_SCHED
}
}

#ifndef PG8_SP2
#define PG8_SP2 true
#endif

constexpr int DM = 2048, NB = 4, SEQ = 4096, DEPTH = 4, CTXL = 256;
constexpr int ML = NB * SEQ, MC = NB * CTXL, MA = ML + MC;
constexpr int OFF_K = 1024, OFF_V = 1152, OFF_S = 1280, OFF_GU = 1792, OFF_GV = 2304, N_IN = 2816;
constexpr int SSM_W = 512, GMLP_W = 512, DFF = 5632, NUP = 2 * DFF, NMOD = 6 * DM, NSH = N_IN + NUP;
constexpr float NORM_EPS = 1e-6f;

constexpr size_t MiB = 1u << 20;
constexpr size_t WS_CTL = 0, CTL_ZERO_BYTES = 1 * MiB;
constexpr size_t WS_MOD = 1 * MiB;
constexpr size_t WS_SA = 2 * MiB;
constexpr size_t WS_SBBR = 3 * MiB, WS_SBBI = 4 * MiB;
constexpr size_t WS_ROPE = 5 * MiB;
constexpr size_t WS_GSV = 6 * MiB;
constexpr size_t WS_SHW = 7 * MiB;
constexpr size_t WS_SHWP = 9 * MiB;
constexpr size_t WS_SSQ = 44 * MiB;
constexpr size_t WS_APOW = 49 * MiB;
constexpr size_t WS_KL = 52 * MiB;
constexpr size_t WS_PT = 54 * MiB;
constexpr size_t WS_ET = 70 * MiB;
constexpr size_t WS_CS = 86 * MiB;
constexpr size_t WS_CY = 120 * MiB;
constexpr size_t WS_WSB = 137 * MiB;
constexpr size_t WS_W = 138 * MiB;
constexpr size_t W_IN_B = (size_t)N_IN * DM * 2, W_OUT_B = (size_t)DM * DM * 2, W_UP_B = (size_t)NUP * DM * 2, W_DN_B = (size_t)DM * DFF * 2, W_GLU_B = (size_t)SSM_W * SSM_W * 2;
constexpr size_t W_LAYER_B = W_IN_B + W_OUT_B + W_UP_B + W_DN_B + W_GLU_B;
constexpr size_t WS_XS = WS_W + ((DEPTH * W_LAYER_B + MiB - 1) / MiB) * MiB;
constexpr size_t WS_A = WS_XS + (size_t)MA * DM * 4;
constexpr size_t WS_Z = WS_A + (size_t)MA * DM * 2;
constexpr size_t WS_CAT = WS_Z + (size_t)MA * N_IN * 2;
constexpr size_t WS_GS = WS_CAT + (size_t)MA * DM * 2;
constexpr size_t WS_ACT = WS_GS + (size_t)MA * 512 * 2;
constexpr size_t WS_EG = WS_ACT + (size_t)MA * DFF * 2;
constexpr size_t WS_EV = WS_EG + (size_t)68 * 44 * 4 * 128 * 4;
constexpr size_t WS_SLAB = WS_EV + (size_t)68 * 44 * 2 * 128 * 4;
constexpr size_t WS_RSTD = WS_SLAB + (size_t)8 * MC * DM * 4;
constexpr size_t WS_END2 = WS_RSTD + (size_t)2 * MA * 4;
static_assert(WS_SHW + (size_t)DEPTH * 5 * NSH * 4 <= WS_SHWP && WS_SHWP + (size_t)32 * DEPTH * 5 * NSH * 4 <= WS_SSQ && WS_SSQ + (size_t)2 * MA * 32 * 4 <= WS_APOW, "d_ws map");
constexpr int CW_BAR = 4096;

constexpr int RING_OFF = 0, RING_BYTES = 131072;
constexpr int RT_OFF = 131072, EDG_OFF = RT_OFF + 1024;
constexpr int RT_OFF_UNUSED = 0;
constexpr int LDSCTL_OFF = 135168, MISC_OFF = LDSCTL_OFF + 320;
constexpr int ROPE_OFF = 136192, ROPE_STRIDE = 36;
constexpr int LDS_BYTES = 156672;
constexpr int NWAVES = 8;

#define GAS __attribute__((address_space(1)))
#define LAS __attribute__((address_space(3)))
typedef unsigned short bf16;
typedef unsigned v4u __attribute__((ext_vector_type(4)));
typedef unsigned v2u __attribute__((ext_vector_type(2)));
typedef float f32x4 __attribute__((ext_vector_type(4)));
typedef float f32x2 __attribute__((ext_vector_type(2)));
#define RLX_AGENT __ATOMIC_RELAXED, __HIP_MEMORY_SCOPE_AGENT
#define LDS_WAIT() asm volatile("s_waitcnt lgkmcnt(0)" ::: "memory")
#define VM_WAIT() asm volatile("s_waitcnt vmcnt(0)" ::: "memory")
#define WG_BAR() asm volatile("s_waitcnt lgkmcnt(0)\n\ts_barrier" ::: "memory")
typedef float f32x2_cv __attribute__((ext_vector_type(2))); typedef __bf16 bf16x2_cv __attribute__((ext_vector_type(2)));
__device__ __forceinline__ unsigned pk2(float lo, float hi) { f32x2_cv v = {lo, hi}; bf16x2_cv b = __builtin_convertvector(v, bf16x2_cv); return __builtin_bit_cast(unsigned, b); }
__device__ __forceinline__ unsigned f2bf(float f) { return pk2(f, 0.f) & 0xffffu; }
__device__ __forceinline__ float bflo(unsigned w) { return __uint_as_float(w << 16); }
__device__ __forceinline__ float bfhi(unsigned w) { return __uint_as_float(w & 0xffff0000u); }
__device__ __forceinline__ float bf2f(bf16 h) { return __uint_as_float((unsigned)h << 16); }
__device__ __forceinline__ float fexp(float x) { return __builtin_amdgcn_exp2f(x * 1.4426950408889634f); }
__device__ __forceinline__ float frcp(float x) { return __builtin_amdgcn_rcpf(x); }
__device__ __forceinline__ float gelu_tanh(float x) { const float u = 0.7978845608028654f * (x + 0.044715f * x * x * x); const float e = fexp(2.f * u); return x - x * frcp(e + 1.f); }
__device__ __forceinline__ float sigmoidf(float x) { return frcp(1.f + fexp(-x)); }
__device__ __forceinline__ float wave_sum(float v) {
    v += __int_as_float(__builtin_amdgcn_mov_dpp(__float_as_int(v), 0xB1, 0xf, 0xf, false));
    v += __int_as_float(__builtin_amdgcn_mov_dpp(__float_as_int(v), 0x4E, 0xf, 0xf, false));
    v += __int_as_float(__builtin_amdgcn_mov_dpp(__float_as_int(v), 0x141, 0xf, 0xf, false));
    v += __int_as_float(__builtin_amdgcn_mov_dpp(__float_as_int(v), 0x140, 0xf, 0xf, false));
    { auto r = __builtin_amdgcn_permlane16_swap(__float_as_uint(v), __float_as_uint(v), false, false); v = __uint_as_float(r[0]) + __uint_as_float(r[1]); }
    { auto r = __builtin_amdgcn_permlane32_swap(__float_as_uint(v), __float_as_uint(v), false, false); v = __uint_as_float(r[0]) + __uint_as_float(r[1]); }
    return v;
}

#define XB_TMO      128
#define XB_XCNT(j)  (256  + 64 * (j))
#define XB_XSUB(j)  (1280 + 64 * (j))
#define XB_XGEN(j)  (2304 + 64 * (j))
#define XB_TOP      3328
#define XB_TOPGEN   3392
#define XCD_BAR_WORDS 3456
#define XB_SPIN_CAP (1u << 18)

__device__ __forceinline__ unsigned xb_ld(unsigned* p)              { return __hip_atomic_load(p, __ATOMIC_RELAXED, __HIP_MEMORY_SCOPE_AGENT); }
__device__ __forceinline__ unsigned xb_add(unsigned* p, unsigned v) { return __hip_atomic_fetch_add(p, v, __ATOMIC_RELAXED, __HIP_MEMORY_SCOPE_AGENT); }
__device__ __forceinline__ unsigned xb_xcc_id() { return (unsigned)__builtin_amdgcn_s_getreg((3 << 11) | 20) & 0xFu; }
#define XB_SPIN(cond, bar) do { unsigned _sp = 0; while (cond) { __builtin_amdgcn_s_sleep(1); \
    if ((++_sp & 255u) == 0u) { if (xb_ld(&(bar)[XB_TMO])) break; if (_sp > XB_SPIN_CAP) { atomicAdd(&(bar)[XB_TMO], 1u); break; } } } } while (0)

struct XcdBarrier {
    unsigned* bar; unsigned x;
    volatile LAS unsigned* st;
};

__device__ __forceinline__ XcdBarrier xcd_barrier_post(unsigned* bar, volatile LAS unsigned* st) {
    XcdBarrier b; b.bar = bar; b.x = xb_xcc_id(); b.st = st;
    if (threadIdx.x == 0) (void)xb_add(&bar[XB_XCNT(b.x)], 1u);
    return b;
}
__device__ __forceinline__ void xcd_barrier_complete(unsigned* bar, unsigned x, unsigned& nloc, unsigned& nx) {
    const unsigned G = gridDim.x * gridDim.y * gridDim.z;
    unsigned sum, cnt, mine, sp = 0u;
    for (;;) {
        sum = 0u; cnt = 0u; mine = 0u;
#pragma unroll
        for (unsigned j = 0; j < 16; ++j) { const unsigned c = xb_ld(&bar[XB_XCNT(j)]); sum += c; cnt += (c > 0u) ? 1u : 0u; mine = (j == x) ? c : mine; }
        if (sum == G) break;
        __builtin_amdgcn_s_sleep(1);
        if ((++sp & 255u) == 0u) { if (xb_ld(&bar[XB_TMO])) break; if (sp > XB_SPIN_CAP) { atomicAdd(&bar[XB_TMO], 1u); break; } }
    }
    nloc = mine > 0u ? mine : 1u; nx = cnt > 0u ? cnt : 1u;
}

__device__ __forceinline__ void xcd_barrier(const XcdBarrier& b) {
    asm volatile("s_waitcnt vmcnt(0)" ::: "memory");
    __syncthreads();
    if (threadIdx.x == 0) {
        unsigned* bar = b.bar;
        __builtin_amdgcn_s_waitcnt(0);
        unsigned nloc = b.st[0], nx = b.st[1];
        if (nloc == 0u) { xcd_barrier_complete(bar, b.x, nloc, nx); b.st[0] = nloc; b.st[1] = nx; }
        const unsigned old = xb_add(&bar[XB_XSUB(b.x)], 1u);
        const unsigned gen = old / nloc;
        if (old + 1u == (gen + 1u) * nloc) {
            __builtin_amdgcn_fence(__ATOMIC_RELEASE, "agent");
            asm volatile("s_waitcnt vmcnt(0)" ::: "memory");
            const unsigned og = xb_add(&bar[XB_TOP], 1u);
            const unsigned tg = og / nx;
            if (og + 1u == (tg + 1u) * nx) xb_add(&bar[XB_TOPGEN], 1u);
            else XB_SPIN(xb_ld(&bar[XB_TOPGEN]) == tg, bar);
            __builtin_amdgcn_fence(__ATOMIC_ACQUIRE, "agent");
            xb_add(&bar[XB_XGEN(b.x)], 1u);
            asm volatile("s_waitcnt vmcnt(0)" ::: "memory");
        } else {
            XB_SPIN(xb_ld(&bar[XB_XGEN(b.x)]) == gen, bar);
            __builtin_amdgcn_fence(__ATOMIC_ACQUIRE, "agent");
            asm volatile("s_waitcnt vmcnt(0)" ::: "memory");
        }
    }
    __syncthreads();
}


enum { I_X = 0, I_C, I_CTX, I_CCTX, I_WADA, I_BADA, I_GMIX, I_GFFN, I_WIN, I_WOUT, I_SINK, I_LRE, I_LIM, I_LDT, I_BRE, I_BIM, I_CRE, I_CIM, I_SD, I_WGLU, I_BGLU,
       I_LNG, I_LNB, I_WS, I_BS, I_WUP, I_CW, I_CB, I_WDN, I_GFIN, N_INPUTS };
struct Args { const float* in[N_INPUTS]; float* out; unsigned char* ws; int ph_lo, ph_hi; };
static_assert(sizeof(Args) == N_INPUTS * 8 + 8 + 8 + 8, "Args has no padding");
struct Frame { LAS unsigned char* lds; int tid, lane, wave, G, bid, gw, NGW, gws, gt, NGT; };

__device__ __forceinline__ bf16* w_in_t(unsigned char* ws, int l) { return (bf16*)(ws + WS_W + (size_t)l * W_LAYER_B); }
__device__ __forceinline__ bf16* w_out_t(unsigned char* ws, int l) { return (bf16*)(ws + WS_W + (size_t)l * W_LAYER_B + W_IN_B); }
__device__ __forceinline__ bf16* w_up_t(unsigned char* ws, int l) { return (bf16*)(ws + WS_W + (size_t)l * W_LAYER_B + W_IN_B + W_OUT_B); }
__device__ __forceinline__ bf16* w_dn_t(unsigned char* ws, int l) { return (bf16*)(ws + WS_W + (size_t)l * W_LAYER_B + W_IN_B + W_OUT_B + W_UP_B); }
__device__ __forceinline__ bf16* w_glu_t(unsigned char* ws, int l) { return (bf16*)(ws + WS_W + (size_t)l * W_LAYER_B + W_IN_B + W_OUT_B + W_UP_B + W_DN_B); }
__device__ __forceinline__ int mod_row(int r) { return r < ML ? (r >> 12) : 4; }

struct TrItem { const float* W; bf16* WT; const float* sh; float* shp; int K, N, item, upperm; };
#define KPERM_SLOT(s_) (128 * (((s_) >> 2) & 1) + 32 * (((s_) >> 6) & 1) + 16 * (((s_) >> 5) & 1) + 4 * (((s_) >> 3) & 3) + ((s_) & 3))
template <bool LIST_B> __device__ __forceinline__ void tr_load(const TrItem& d, int lane, float (&v)[128]) {
    const int nblk = d.N / 64, kb = d.item / nblk, nb = d.item % nblk, k0 = 128 * kb, n0 = 64 * nb; const int kp = 256 * (kb >> 1) + 64 * (kb & 1);
#pragma unroll
    for (int i = 0; i < 128; ++i) v[i] = d.W[(size_t)(LIST_B ? kp + KPERM_SLOT(i) : k0 + i) * d.N + n0 + lane];
}
__device__ __forceinline__ void tr_finish(const TrItem& d, LAS unsigned* scr, LAS float* shl, int lane, const float (&v)[128]) {
    const int K = d.K, nblk = d.N / 64, kb = d.item / nblk, nb = d.item % nblk, k0 = 128 * kb, n0 = 64 * nb;
    const int n0o = d.upperm != 1 ? n0 : (n0 < DFF ? 256 * (n0 >> 7) + (n0 & 127) : 256 * ((n0 - DFF) >> 7) + 128 + ((n0 - DFF) & 127));
#define K32_SLOT(s_) (((s_) & ~31) + 16 * (((s_) >> 2) & 1) + 4 * (((s_) >> 3) & 3) + ((s_) & 3))
    if (d.upperm == 2) {
#pragma unroll
        for (int i = 0; i < 64; ++i) scr[i * 65 + lane] = pk2(v[K32_SLOT(2 * i)], v[K32_SLOT(2 * i + 1)]);
    } else {
#pragma unroll
        for (int i = 0; i < 64; ++i) scr[i * 65 + lane] = pk2(v[2 * i], v[2 * i + 1]);
    }
    if (d.sh) {
#pragma unroll
        for (int m = 0; m < 5; ++m) { const int kp = 256 * (kb >> 1) + 64 * (kb & 1); shl[m * 128 + lane] = d.sh[(size_t)m * NMOD + kp + KPERM_SLOT(lane)]; shl[m * 128 + 64 + lane] = d.sh[(size_t)m * NMOD + kp + KPERM_SLOT(64 + lane)]; } }
    LDS_WAIT(); asm volatile("" ::: "memory");
    const int c = lane & 15;
#pragma unroll
    for (int j = 0; j < 16; ++j) { const int n = (lane >> 4) + 4 * j; const LAS unsigned* s = scr + (4 * c) * 65 + n;
        v4u o; o.x = s[0]; o.y = s[65]; o.z = s[2 * 65]; o.w = s[3 * 65];
        *(GAS v4u*)(d.WT + (size_t)(n0o + n) * K + k0 + 8 * c) = o; }
    if (d.sh) { float p[5] = {0.f, 0.f, 0.f, 0.f, 0.f};
#pragma unroll
        for (int i4 = 0; i4 < 32; ++i4) {
#pragma unroll
            for (int m = 0; m < 5; ++m) { const f32x4 sv = *(const LAS f32x4*)(shl + m * 128 + 4 * i4); p[m] += (sv.x * v[4 * i4] + sv.y * v[4 * i4 + 1]) + (sv.z * v[4 * i4 + 2] + sv.w * v[4 * i4 + 3]); } }
#pragma unroll
        for (int m = 0; m < 5; ++m) d.shp[(size_t)m * NSH + n0o + lane] = p[m]; }
    LDS_WAIT(); asm volatile("" ::: "memory");
}
__device__ __forceinline__ TrItem tr_decode_a(const Args& a, int it) {
    constexpr int I_OUT = (DM / 128) * (DM / 64), I_DN = (DFF / 128) * (DM / 64), I_GLU = (SSM_W / 128) * (SSM_W / 64), I_LA = I_OUT + I_DN + I_GLU;
    const int l = it / I_LA; int r = it % I_LA; unsigned char* ws = a.ws;
    if (r < I_OUT) return TrItem{a.in[I_WOUT] + (size_t)l * DM * DM, w_out_t(ws, l), nullptr, nullptr, DM, DM, r, 0}; r -= I_OUT;
    if (r < I_DN) return TrItem{a.in[I_WDN] + (size_t)l * DFF * DM, w_dn_t(ws, l), nullptr, nullptr, DFF, DM, r, 2}; r -= I_DN;
    return TrItem{a.in[I_WGLU] + (size_t)l * SSM_W * SSM_W, w_glu_t(ws, l), nullptr, nullptr, SSM_W, SSM_W, r, 0};
}
__device__ __forceinline__ TrItem tr_decode_b(const Args& a, int it) {
    constexpr int I_IN = (DM / 128) * (N_IN / 64), I_UP = (DM / 128) * (NUP / 64), I_LB = I_IN + I_UP;
    const int l = it / I_LB; int r = it % I_LB; unsigned char* ws = a.ws; const float* modl = (const float*)(ws + WS_MOD) + (size_t)l * 5 * NMOD; float* SHWP = (float*)(ws + WS_SHWP);
    if (r < I_IN) { const int kb = r / (N_IN / 64); return TrItem{a.in[I_WIN] + (size_t)l * DM * N_IN, w_in_t(ws, l), modl, SHWP + (size_t)(kb * DEPTH + l) * 5 * NSH, DM, N_IN, r, 0}; } r -= I_IN;
    const int kb = r / (NUP / 64); return TrItem{a.in[I_WUP] + (size_t)l * DM * NUP, w_up_t(ws, l), modl + 3 * DM, SHWP + (size_t)(kb * DEPTH + l) * 5 * NSH + N_IN, DM, NUP, r, 1};
}
template <bool LIST_B> __device__ __forceinline__ void tr_run(const Frame& F, const Args& a, LAS unsigned* scr, LAS float* shl, int it0, int it1, int gw, int ngw) {
#pragma unroll 1
    for (int it = it0 + gw; it < it1; it += ngw) { float v[128];
        tr_load<LIST_B>(LIST_B ? tr_decode_b(a, it) : tr_decode_a(a, it), F.lane, v);
        tr_finish(LIST_B ? tr_decode_b(a, it) : tr_decode_a(a, it), scr, shl, F.lane, v);
    }
}
constexpr int TR_I_LA = (DM / 128) * (DM / 64) + (DFF / 128) * (DM / 64) + (SSM_W / 128) * (SSM_W / 64);
__device__ __forceinline__ void conv_next_a(const Frame& F, const Args& a, int ln, int h, int first, int nblk) {
    const int lo = first < F.G ? first : 0, cnt = F.G - lo < nblk ? F.G - lo : nblk;
    if (F.bid < lo || F.bid >= lo + cnt) return;
    constexpr int SPL = 1408;
    const int it0 = ln * TR_I_LA + (h ? SPL : 0), it1 = ln * TR_I_LA + (h ? TR_I_LA : SPL);
    int gwl = (F.bid - lo) * NWAVES + F.wave, ngwl = cnt * NWAVES;
    if (h == 0 && F.G == 256) {
        if (F.wave < 2 || (F.wave == 2 && F.bid < 16)) return;
        gwl = F.wave >= 3 ? (F.wave - 3) * 120 + F.bid : 600 + F.bid - 16; ngwl = 704; }
    tr_run<false>(F, a, (LAS unsigned*)(F.lds + RING_OFF + F.wave * 16640), nullptr, it0, it1, gwl, ngwl);
}
__device__ __forceinline__ void p0a_conv(const Frame& F, const Args& a) {
    WG_BAR();
    tr_run<false>(F, a, (LAS unsigned*)(F.lds + RING_OFF + F.wave * 16640), nullptr, 0, TR_I_LA, F.gw, F.NGW);
}
__device__ __forceinline__ void p0a(const Frame& F, const Args& a) {
    unsigned char* ws = a.ws;
    { LAS float* SC = (LAS float*)(F.lds); LAS f32x4* PP = (LAS f32x4*)(F.lds + 40960); float* MOD = (float*)(ws + WS_MOD);
      const float* cc = a.in[I_C]; const float* cx = a.in[I_CCTX]; const float* wada = a.in[I_WADA]; const float* bada = a.in[I_BADA];
      for (int i = F.tid; i < 5 * DM; i += NWAVES * 64) { const int m = i >> 11, k = i & (DM - 1); const float c = m < 4 ? cc[m * DM + k] : cx[k]; SC[i] = c * sigmoidf(c); }
      WG_BAR();
#pragma unroll 1
      for (int it = F.bid; it < DEPTH * 64; it += F.G) { const int l = it >> 6, nb = it & 63, k0 = 256 * F.wave;
          const int ln = F.lane < 48 ? F.lane : 47;
          const f32x4* w = (const f32x4*)(wada + ((size_t)l * DM + k0) * NMOD + nb * 192) + ln; f32x4 acc[5];
#pragma unroll
          for (int m = 0; m < 5; ++m) acc[m] = (f32x4){0.f, 0.f, 0.f, 0.f};
#pragma unroll 32
          for (int kk = 0; kk < 256; ++kk) { const f32x4 wv = __builtin_nontemporal_load(w + (size_t)kk * (NMOD / 4));
#pragma unroll
              for (int m = 0; m < 5; ++m) acc[m] = acc[m] + wv * SC[m * DM + k0 + kk]; }
#pragma unroll
          for (int m = 0; m < 5; ++m) PP[(F.wave * 5 + m) * 64 + F.lane] = acc[m];
          WG_BAR();
          if (F.tid < 320 && (F.tid & 63) < 48) { const int m = F.tid >> 6, nn = F.tid & 63; f32x4 s = *(const f32x4*)(bada + l * NMOD + nb * 192 + 4 * nn);
#pragma unroll
              for (int w8 = 0; w8 < 8; ++w8) s = s + PP[(w8 * 5 + m) * 64 + nn];
              *(f32x4*)(MOD + (size_t)(l * 5 + m) * NMOD + nb * 192 + 4 * nn) = s; }
          WG_BAR();
      } }
    { float* SA = (float*)(ws + WS_SA); float* SBR = (float*)(ws + WS_SBBR); float* SBI = (float*)(ws + WS_SBBI); float* APW = (float*)(ws + WS_APOW);
      if (F.wave == 0) {
#pragma unroll 1
      for (int i = F.bid * 64 + F.lane; i < DEPTH * 2 * 32 * 64; i += F.G * 64) {
          const double lr = a.in[I_LRE][i], li = a.in[I_LIM][i], dt = exp((double)a.in[I_LDT][i >> 6]);
          const double mag = exp(lr * dt), ar = mag * cos(li * dt), ai = mag * sin(li * dt); const double den = lr * lr + li * li, nr = ar - 1.0;
          const double fr = (nr * lr + ai * li) / den, fi = (ai * lr - nr * li) / den;
          SA[2 * i] = (float)ar; SA[2 * i + 1] = (float)ai;
          double pr = 1.0, pi = 0.0;
#pragma unroll 1
          for (int k = 0; k <= 16; ++k) { APW[(size_t)i * 34 + 2 * k] = (float)pr; APW[(size_t)i * 34 + 2 * k + 1] = (float)pi; const double nr2 = pr * ar - pi * ai, ni2 = pr * ai + pi * ar; pr = nr2; pi = ni2; }
#pragma unroll 4
          for (int h = 0; h < 16; ++h) { const double br = a.in[I_BRE][(size_t)i * 16 + h], bi = a.in[I_BIM][(size_t)i * 16 + h];
              SBR[(size_t)i * 16 + h] = (float)(fr * br - fi * bi); SBI[(size_t)i * 16 + h] = (float)(fr * bi + fi * br); }
      } } }
    { const float* wsf = a.in[I_WS]; bf16* WSB = (bf16*)(ws + WS_WSB); for (int i = F.gt; i < DEPTH * 4 * 128 * 128; i += F.NGT) WSB[i] = (bf16)f2bf(wsf[i]); }
    { float* RC = (float*)(ws + WS_ROPE); float* RS = RC + SEQ * 32;
      for (int i = F.gt; i < SEQ * 32; i += F.NGT) { const int t = i >> 5, j = i & 31, ax = j >> 4, f = j & 15;
          const float inv = powf(10000.f, -(float)f / 16.f); const float ang = (float)(ax == 0 ? (t >> 6) : (t & 63)) * inv;
          RC[i] = cosf(ang); RS[i] = sinf(ang); } }
}

__device__ __forceinline__ void p0b_conv(const Frame& F, const Args& a) {
    unsigned char* ws = a.ws; const float* MOD = (const float*)(ws + WS_MOD); float* SHWP = (float*)(ws + WS_SHWP);
    { constexpr int I_LB = (DM / 128) * (N_IN / 64) + (DM / 128) * (NUP / 64);
      tr_run<true>(F, a, (LAS unsigned*)(F.lds + RING_OFF + F.wave * 16640), (LAS float*)(F.lds + ROPE_OFF + F.wave * 2560), 0, DEPTH * I_LB, F.gw, F.NGW); }
}
__device__ __forceinline__ void p0b(const Frame& F, const Args& a) {
    unsigned char* ws = a.ws; const float* MOD = (const float*)(ws + WS_MOD);
    { float* GSV = (float*)(ws + WS_GSV);
      for (int i = F.gt; i < DEPTH * 2 * 5 * DM; i += F.NGT) { const int k = i & (DM - 1), m = (i >> 11) % 5, w = (i / (5 * DM)) & 1, l = i / (10 * DM);
          GSV[i] = (w ? a.in[I_GFFN][l * DM + k] : a.in[I_GMIX][l * DM + k]) * (1.f + MOD[(size_t)(l * 5 + m) * NMOD + (w ? 4 : 1) * DM + k]); } }
    { bf16* A = (bf16*)(ws + WS_A);
      for (int r = F.gw; r < MA; r += F.NGW) {
          const float* xrow = r < ML ? a.in[I_X] + (size_t)r * DM : a.in[I_CTX] + (size_t)(r - ML) * DM;
          const f32x4* xr = (const f32x4*)xrow + F.lane; const float* gm = a.in[I_GMIX]; const float* sc = MOD + (size_t)mod_row(r) * NMOD + DM; v2u* o = (v2u*)(A + (size_t)r * DM) + (16 * ((F.lane >> 3) & 3) + 8 * ((F.lane >> 2) & 1) + 2 * (F.lane & 3) + (F.lane >> 5)); float s = 0.f;
          f32x4 v[8], gg[8];
#pragma unroll
          for (int j = 0; j < 8; ++j) { v[j] = xr[64 * j]; gg[j] = *(const f32x4*)(gm + 4 * F.lane + 256 * j) * (*(const f32x4*)(sc + 4 * F.lane + 256 * j) + 1.f); }
#pragma unroll
          for (int j = 0; j < 8; ++j) { s += (v[j].x * v[j].x + v[j].y * v[j].y) + (v[j].z * v[j].z + v[j].w * v[j].w); const f32x4 y = v[j] * gg[j]; v2u w; w.x = pk2(y.x, y.y); w.y = pk2(y.z, y.w); o[64 * j] = w; }
          s = wave_sum(s); if (F.lane == 0) ((float*)(ws + WS_RSTD))[r] = __builtin_amdgcn_rsqf(s * (1.f / DM) + NORM_EPS);
      } }
}
__device__ __forceinline__ void p0c(const Frame& F, const Args& a) {
    unsigned char* ws = a.ws;
    { const float* SHWP = (const float*)(ws + WS_SHWP); float* SHW = (float*)(ws + WS_SHW);
      for (int i = F.gt; i < DEPTH * 5 * NSH; i += F.NGT) { float s = 0.f;
#pragma unroll 8
          for (int kb = 0; kb < 16; ++kb) s += SHWP[(size_t)kb * DEPTH * 5 * NSH + i];
          SHW[i] = s; } }

}

__device__ __forceinline__ void conv_fixup(const Frame& F, const Args& a, int l) {
    const float* EG = (const float*)(a.ws + WS_EG); const float* EV = (const float*)(a.ws + WS_EV); bf16* ACT = (bf16*)(a.ws + WS_ACT); const float* cw = a.in[I_CW] + (size_t)l * 3 * DFF; const float* cb = a.in[I_CB] + (size_t)l * DFF;
    for (int idx = F.gt; idx < 60 * 2 * DFF; idx += F.NGT) { const int c = idx % DFF, wh = (idx / DFF) & 1, bi = idx / (2 * DFF); const int pm = 16 * (bi / 15) + (bi % 15), pn = c >> 7, cc = c & 127;
        const float* ep = EG + ((size_t)(pm * 44 + pn) * 4) * 128 + cc; const float* en = EG + ((size_t)((pm + 1) * 44 + pn) * 4) * 128 + cc;
        float gm, g0, gp, vv;
        if (wh == 0) { gm = ep[2 * 128]; g0 = ep[3 * 128]; gp = en[0]; vv = EV[((size_t)(pm * 44 + pn) * 2 + 1) * 128 + cc]; }
        else { gm = ep[3 * 128]; g0 = en[0]; gp = en[128]; vv = EV[((size_t)((pm + 1) * 44 + pn) * 2) * 128 + cc]; }
        const float pre = cw[c] * gm + cw[DFF + c] * g0 + cw[2 * DFF + c] * gp + cb[c];
        { const int r = 256 * (pm + 1) - 1 + wh, c32 = c & 31, pos = (c & ~31) + 8 * ((c32 >> 2) & 3) + 4 * (c32 >> 4) + (c32 & 3);
          *(bf16*)((char*)ACT + (size_t)(r >> 1) * (4 * DFF) + (size_t)(pos >> 5) * 128 + (r & 1) * 64 + (pos & 31) * 2) = (bf16)f2bf(pre * sigmoidf(pre) * vv); } }
}
__device__ __forceinline__ void lat_rstd(const Frame& F, const Args& a, int stage) {
    const float* SSQ = (const float*)(a.ws + WS_SSQ) + (stage == 0 ? (size_t)MA * 32 : 0); float* RST = (float*)(a.ws + WS_RSTD) + (stage == 0 ? MA : 0);
    for (int r = F.gt; r < ML; r += F.NGT) { const f32x4* p = (const f32x4*)(SSQ + (size_t)r * 32); f32x4 s = p[0];
#pragma unroll
        for (int j = 1; j < 8; ++j) s = s + p[j];
        RST[r] = __builtin_amdgcn_rsqf(((s.x + s.y) + (s.z + s.w)) * (1.f / DM) + NORM_EPS); }
}
__device__ __forceinline__ void ctx_reduce(const Frame& F, const Args& a, int l, int stage) {
    const float* SL = (const float*)(a.ws + WS_SLAB); float* XS = (float*)(a.ws + WS_XS); bf16* A = (bf16*)(a.ws + WS_A); const int nks = 8;
    const float* gate = (const float*)(a.ws + WS_MOD) + (size_t)(l * 5 + 4) * NMOD + (stage == 0 ? 2 : 5) * DM;
    const float* gsn = (const float*)(a.ws + WS_GSV) + (size_t)((stage == 0 ? l * 2 + 1 : (l + 1) * 2) * 5 + 4) * DM;
    float* RST = (float*)(a.ws + WS_RSTD) + (stage == 0 ? MA : 0);
    for (int r = F.gw; r < MC; r += F.NGW) { const size_t row = (size_t)ML + r;
        const float* xr = (l == 0 && stage == 0) ? a.in[I_CTX] + (size_t)r * DM : XS + row * DM; float s = 0.f;
        f32x4 pp[8], xx[8];
#pragma unroll
        for (int j = 0; j < 8; ++j) { const int k = 4 * F.lane + 256 * j; pp[j] = *(const f32x4*)(SL + (size_t)r * DM + k); xx[j] = *(const f32x4*)(xr + k);
            for (int ks = 1; ks < nks; ++ks) pp[j] = pp[j] + *(const f32x4*)(SL + ((size_t)ks * MC + r) * DM + k); }
#pragma unroll
        for (int j = 0; j < 8; ++j) { const int k = 4 * F.lane + 256 * j; const f32x4 p = pp[j];
            const f32x4 x = xx[j] + *(const f32x4*)(gate + k) * p; *(f32x4*)(XS + row * DM + k) = x; s += (x.x * x.x + x.y * x.y) + (x.z * x.z + x.w * x.w);
            const f32x4 y = x * *(const f32x4*)(gsn + k); v2u w; w.x = pk2(y.x, y.y); w.y = pk2(y.z, y.w); *(v2u*)(A + row * DM + 256 * j + 4 * (16 * ((F.lane >> 3) & 3) + 8 * ((F.lane >> 2) & 1) + 2 * (F.lane & 3) + (F.lane >> 5))) = w; }
        s = wave_sum(s); if (F.lane == 0) RST[row] = __builtin_amdgcn_rsqf(s * (1.f / DM) + NORM_EPS);
    }
}
__device__ __forceinline__ void final_norm(const Frame& F, const Args& a) {
    const float* XS = (const float*)(a.ws + WS_XS); const float* g = a.in[I_GFIN];
    f32x4 gg[8];
#pragma unroll
    for (int j = 0; j < 8; ++j) gg[j] = *(const f32x4*)(g + 4 * F.lane + 256 * j);
#pragma unroll 1
    for (int r = F.gw; r < ML; r += 2 * F.NGW) {
        const int r1 = r + F.NGW < ML ? r + F.NGW : r; f32x4 v0[8], v1[8]; float s0 = 0.f, s1 = 0.f;
        const f32x4* x0 = (const f32x4*)(XS + (size_t)r * DM) + F.lane; const f32x4* x1 = (const f32x4*)(XS + (size_t)r1 * DM) + F.lane;
#pragma unroll
        for (int j = 0; j < 8; ++j) { v0[j] = x0[64 * j]; v1[j] = x1[64 * j]; }
#pragma unroll
        for (int j = 0; j < 8; ++j) { s0 += (v0[j].x * v0[j].x + v0[j].y * v0[j].y) + (v0[j].z * v0[j].z + v0[j].w * v0[j].w); s1 += (v1[j].x * v1[j].x + v1[j].y * v1[j].y) + (v1[j].z * v1[j].z + v1[j].w * v1[j].w); }
        const float rs0 = __builtin_amdgcn_rsqf(wave_sum(s0) * (1.f / DM) + NORM_EPS), rs1 = __builtin_amdgcn_rsqf(wave_sum(s1) * (1.f / DM) + NORM_EPS);
        f32x4* o0 = (f32x4*)(a.out + (size_t)r * DM) + F.lane; f32x4* o1 = (f32x4*)(a.out + (size_t)r1 * DM) + F.lane;
#pragma unroll
        for (int j = 0; j < 8; ++j) { o0[64 * j] = v0[j] * rs0 * gg[j]; o1[64 * j] = v1[j] * rs1 * gg[j]; }
    }
}
namespace att {
typedef short bf16x8 __attribute__((ext_vector_type(8)));
typedef short s16x4 __attribute__((ext_vector_type(4)));
typedef float f32x16 __attribute__((ext_vector_type(16)));
typedef unsigned u32x4 __attribute__((ext_vector_type(4)));
constexpr int SLOTB = 8192, LDS_K = 0, LDS_V = 3 * SLOTB, LDS_WS = 6 * SLOTB, LDS_OST = LDS_WS + 8 * 64 * 4, LDS_TOTAL = LDS_OST + 8 * 4096;
constexpr float C2 = 0.125f * 1.4426950408889634f, LOG2E = 1.4426950408889634f;
__device__ __forceinline__ int crow(int r, int hi) { return (r & 3) + 8 * (r >> 2) + 4 * hi; }
__device__ __forceinline__ void glds16(const void* gsrc, unsigned lds_dst) { unsigned keep;
    asm volatile("s_mov_b32 %0, m0\n\ts_mov_b32 m0, %2\n\ts_nop 0\n\tglobal_load_lds_dwordx4 %1, off\n\ts_mov_b32 m0, %0" : "=&s"(keep) : "v"(gsrc), "s"(lds_dst) : "memory"); }
typedef float f32x2_t __attribute__((ext_vector_type(2))); typedef __bf16 bf16x2_t __attribute__((ext_vector_type(2)));
__device__ __forceinline__ unsigned cvtpk_s(float lo, float hi) { f32x2_t v = {lo, hi}; bf16x2_t b = __builtin_convertvector(v, bf16x2_t); return __builtin_bit_cast(unsigned, b); }
#define ATT_SBAR() __builtin_amdgcn_sched_barrier(0)
__device__ __forceinline__ void pv2(f32x16 (&o)[2][2], int vb, const bf16x8 (&pa)[2][4]) {
#pragma unroll
    for (int d0 = 0; d0 < 2; ++d0) { s16x4 lo[4], hi[4];
#pragma unroll
        for (int ks = 0; ks < 4; ++ks) {
            asm volatile("ds_read_b64_tr_b16 %0,%1 offset:%c2" : "=&v"(lo[ks]) : "v"(vb), "i"(d0 * 4096 + ks * 1024) : "memory");
            asm volatile("ds_read_b64_tr_b16 %0,%1 offset:%c2" : "=&v"(hi[ks]) : "v"(vb), "i"(d0 * 4096 + ks * 1024 + 512) : "memory"); }
        asm volatile("s_waitcnt lgkmcnt(0)" ::: "memory"); ATT_SBAR();
#pragma unroll
        for (int ks = 0; ks < 4; ++ks) { const bf16x8 vf = (bf16x8){lo[ks][0], lo[ks][1], lo[ks][2], lo[ks][3], hi[ks][0], hi[ks][1], hi[ks][2], hi[ks][3]};
            o[0][d0] = __builtin_amdgcn_mfma_f32_32x32x16_bf16(pa[0][ks], vf, o[0][d0], 0, 0, 0);
            o[1][d0] = __builtin_amdgcn_mfma_f32_32x32x16_bf16(pa[1][ks], vf, o[1][d0], 0, 0, 0); }
    }
}
__device__ __forceinline__ void unit(LAS unsigned char* shm, const bf16* Z, bf16* CAT, float sinkv, int qrow0, int qpos0, int krow_ctx, int krow_lat, int kh, bool latent, int wid, int lane) {
    constexpr float THR = 8.f;
    const int r32 = lane & 31, hi = lane >> 5; const int head = kh * 8 + wid;
    const unsigned lds0 = (unsigned)(uintptr_t)shm;
    LAS float* wsf = (LAS float*)(shm + LDS_WS) + wid * 64;
    bf16x8 qr[2][4];
    int jlo = 0, nband = 0;
    if (latent) { const int j = qpos0 >> 6; jlo = j - 2 < 0 ? 0 : j - 2; const int jhi = j + 2 > 63 ? 63 : j + 2; nband = jhi - jlo + 1; }
    const int NT = 4 + nband;
    const size_t koff = (size_t)lane * N_IN + OFF_K + kh * 64 + wid * 8;
    const size_t voff = (size_t)(16 * (wid & 3) + (lane >> 2)) * N_IN + OFF_V + kh * 64 + (wid >> 2) * 32 + (lane & 3) * 8;
    const unsigned kdst = lds0 + LDS_K + wid * 1024, vdst = lds0 + LDS_V + wid * 1024;
#define ATT_TROW(t) ((t) < 4 ? krow_ctx + 64 * (t) : krow_lat + 64 * (jlo + (t) - 4))
#define ATT_DMA(t, slot) do { const int tr_ = ATT_TROW(t); glds16(Z + (size_t)tr_ * N_IN + koff, (unsigned)__builtin_amdgcn_readfirstlane(kdst + (slot))); glds16(Z + (size_t)tr_ * N_IN + voff, (unsigned)__builtin_amdgcn_readfirstlane(vdst + (slot))); } while (0)
    const int vb0 = (int)(lds0 + LDS_V) + ((lane >> 4) & 1) * 32 + (lane & 3) * 8 + (4 * hi + ((lane & 15) >> 2)) * 64;
    float m[2] = {0.f, 0.f}, l[2] = {0.f, 0.f}; f32x16 o[2][2]; o[0][0] = f32x16{}; o[0][1] = f32x16{}; o[1][0] = f32x16{}; o[1][1] = f32x16{};
    f32x16 negm[2]; negm[0] = f32x16{}; negm[1] = f32x16{};
    ATT_DMA(0, 0);
#pragma unroll
    for (int x = 0; x < 2; ++x) { const bf16* Qw = Z + (size_t)(qrow0 + 32 * x + r32) * N_IN + head * 64 + hi * 8;
#pragma unroll
        for (int d0 = 0; d0 < 4; ++d0) qr[x][d0] = *(const bf16x8*)(Qw + d0 * 16); }
    asm volatile("s_waitcnt vmcnt(0)" ::: "memory");
    ATT_DMA(1, SLOTB);
    int slot = 0, slot2 = 2 * SLOTB;
#pragma unroll 1
    for (int t = 0; t < NT; ++t) {
        if (t + 1 < NT) { asm volatile("s_waitcnt vmcnt(2)\n\ts_barrier" ::: "memory"); } else { asm volatile("s_waitcnt vmcnt(0)\n\ts_barrier" ::: "memory"); }
        if (t + 2 < NT) ATT_DMA(t + 2, slot2);
        f32x16 p[2][2]; p[0][0] = negm[0]; p[0][1] = negm[0]; p[1][0] = negm[1]; p[1][1] = negm[1];
        { const LAS unsigned char* kb = shm + LDS_K + slot + hi * 1024 + r32 * 16;
#pragma unroll
          for (int d0 = 0; d0 < 4; ++d0) { const bf16x8 b0 = *(const LAS bf16x8*)(kb + d0 * 2048), b1 = *(const LAS bf16x8*)(kb + d0 * 2048 + 512);
#pragma unroll
              for (int x = 0; x < 2; ++x) { p[x][0] = __builtin_amdgcn_mfma_f32_32x32x16_bf16(b0, qr[x][d0], p[x][0], 0, 0, 0); p[x][1] = __builtin_amdgcn_mfma_f32_32x32x16_bf16(b1, qr[x][d0], p[x][1], 0, 0, 0); } } }
        bf16x8 pa[2][4];
#pragma unroll
        for (int x = 0; x < 2; ++x) {
            if (t >= 4) { const int kp0 = 64 * (jlo + t - 4), qx0 = qpos0 + 32 * x;
                if (kp0 + 63 - qx0 > 128 || qx0 + 31 - kp0 > 128) {
#pragma unroll
                    for (int r = 0; r < 16; ++r) { const int d = kp0 + crow(r, hi) - (qx0 + r32); if (d > 128 || d < -128) p[x][0][r] = -INFINITY; if (d + 32 > 128 || d + 32 < -128) p[x][1][r] = -INFINITY; } } }
            float mx = __builtin_fmaxf(__builtin_fmaxf(p[x][0][0], p[x][1][0]), __builtin_fmaxf(p[x][0][1], p[x][1][1]));
#pragma unroll
            for (int r = 2; r < 16; r += 2) mx = __builtin_fmaxf(__builtin_fmaxf(mx, __builtin_fmaxf(p[x][0][r], p[x][1][r])), __builtin_fmaxf(p[x][0][r + 1], p[x][1][r + 1]));
            { auto rr = __builtin_amdgcn_permlane32_swap(__float_as_uint(mx), __float_as_uint(mx), false, false); mx = __builtin_fmaxf(__uint_as_float(rr[0]), __uint_as_float(rr[1])); }
            if (__any(t == 0 || mx > THR)) {
                const float d = t == 0 ? mx : __builtin_fmaxf(mx, 0.f), f = t == 0 ? 0.f : __builtin_amdgcn_exp2f(-d); m[x] += d; l[x] *= f;
#pragma unroll
                for (int r = 0; r < 16; ++r) { p[x][0][r] -= d; p[x][1][r] -= d; negm[x][r] = -m[x]; }
                if (t > 0) { if (hi == 0) wsf[r32] = f;
#pragma unroll
                    for (int r = 0; r < 16; ++r) { const float g = wsf[crow(r, hi)]; o[x][0][r] *= g; o[x][1][r] *= g; } } }
            float rs = 0.f;
#pragma unroll
            for (int r = 0; r < 16; ++r) { p[x][0][r] = __builtin_amdgcn_exp2f(p[x][0][r]); p[x][1][r] = __builtin_amdgcn_exp2f(p[x][1][r]); rs += p[x][0][r] + p[x][1][r]; }
            l[x] += rs;
#pragma unroll
            for (int k = 0; k < 4; ++k) { const int h2 = k >> 1, b8 = (k & 1) * 8;
                const u32x4 w = (u32x4){cvtpk_s(p[x][h2][b8 + 0], p[x][h2][b8 + 1]), cvtpk_s(p[x][h2][b8 + 2], p[x][h2][b8 + 3]), cvtpk_s(p[x][h2][b8 + 4], p[x][h2][b8 + 5]), cvtpk_s(p[x][h2][b8 + 6], p[x][h2][b8 + 7])};
                pa[x][k] = __builtin_bit_cast(bf16x8, w); }
        }
        pv2(o, vb0 + slot, pa);
        asm volatile("s_waitcnt lgkmcnt(0)" ::: "memory");
        { const int s_ = slot; slot = slot == 2 * SLOTB ? 0 : slot + SLOTB; slot2 = s_; }
    }
#undef ATT_DMA
#undef ATT_TROW
#pragma unroll
    for (int x = 0; x < 2; ++x) { float lx = l[x];
        { auto rr = __builtin_amdgcn_permlane32_swap(__float_as_uint(lx), __float_as_uint(lx), false, false); lx = __uint_as_float(rr[0]) + __uint_as_float(rr[1]); }
        lx += __builtin_amdgcn_exp2f(sinkv * LOG2E - m[x]);
        if (hi == 0) wsf[32 + r32] = lx;
        asm volatile("s_waitcnt lgkmcnt(0)" ::: "memory");
        float rli[16];
#pragma unroll
        for (int r = 0; r < 16; ++r) rli[r] = __builtin_amdgcn_rcpf(wsf[32 + crow(r, hi)]);
        bf16* Ow = CAT + (size_t)(qrow0 + 32 * x) * DM + head * 64;
        LAS bf16* stg = (LAS bf16*)(shm + LDS_OST) + wid * 2048;
#pragma unroll
        for (int r = 0; r < 16; ++r) { const int orow = crow(r, hi);
#pragma unroll
            for (int d0 = 0; d0 < 2; ++d0) stg[orow * 64 + d0 * 32 + r32] = (bf16)f2bf(o[x][d0][r] * rli[r]); }
        asm volatile("s_waitcnt lgkmcnt(0)" ::: "memory");
#pragma unroll
        for (int i = 0; i < 4; ++i) { const int row = i * 8 + (lane >> 3), ch = lane & 7; const u32x4 v = *(const LAS u32x4*)(stg + row * 64 + ch * 8); *(u32x4*)(Ow + (size_t)row * DM + ch * 8) = v; }
        asm volatile("s_waitcnt lgkmcnt(0)" ::: "memory"); }
    asm volatile("s_waitcnt lgkmcnt(0)\n\ts_barrier" ::: "memory");
}
#undef ATT_SBAR
}
__device__ __forceinline__ void attn_phase(const Frame& F, const Args& a, int l, bool with_ctx) {
    const bf16* Z = (const bf16*)(a.ws + WS_Z); bf16* CAT = (bf16*)(a.ws + WS_CAT); const float* sink = a.in[I_SINK] + l * 16;
    const int v = (F.G % 8 == 0) ? (F.bid % 8) * (F.G / 8) + F.bid / 8 : F.bid;
    const int NU = 512 + (with_ctx ? 32 : 0);
#pragma unroll 1
    for (int ui = v; ui < NU; ui += F.G) {
        const bool lat = ui < 512; const int uc = ui - 512;
        const int b = lat ? ui >> 7 : uc >> 3, kh = lat ? (ui >> 6) & 1 : (uc >> 2) & 1, qb = lat ? ui & 63 : uc & 3;
        att::unit(F.lds + RING_OFF, Z, CAT, sink[kh * 8 + F.wave], (lat ? b * SEQ : ML + b * CTXL) + qb * 64, lat ? qb * 64 : 0, ML + b * CTXL, b * SEQ, kh, lat, F.wave, F.lane);
    }
}

typedef short bf16x8_t __attribute__((ext_vector_type(8)));
__device__ __forceinline__ void s5_tables(const Frame& F, const Args& a) {
    unsigned char* ws = a.ws; const float* AP = (const float*)(ws + WS_APOW); const float* SBR = (const float*)(ws + WS_SBBR); const float* SBI = (const float*)(ws + WS_SBBI);
    const float* cre = a.in[I_CRE]; const float* cim = a.in[I_CIM];
    bf16* KL = (bf16*)(ws + WS_KL); bf16* PT = (bf16*)(ws + WS_PT); bf16* ET = (bf16*)(ws + WS_ET);
    LAS float* L = (LAS float*)(F.lds + RING_OFF);
    constexpr int DS = 6272;
    WG_BAR();
#pragma unroll 1
    for (int lg = F.bid; lg < DEPTH * 32; lg += F.G) { const int l = lg >> 5, g = lg & 31;
        for (int i = F.tid; i < 2 * DS; i += NWAVES * 64) { const int d = i / DS, r = i % DS; const int i0 = ((l * 2 + d) * 32 + g) * 64; float v;
            if (r < 2176) v = AP[(size_t)i0 * 34 + r]; else if (r < 3200) v = SBR[(size_t)i0 * 16 + r - 2176]; else if (r < 4224) v = SBI[(size_t)i0 * 16 + r - 3200];
            else if (r < 5248) v = cre[(size_t)(i0 >> 6) * 1024 + r - 4224]; else v = cim[(size_t)(i0 >> 6) * 1024 + r - 5248];
            L[i] = v; }
        WG_BAR();
        { const int d = F.tid >> 8, k = (F.tid >> 4) & 15, h = F.tid & 15; const LAS float* D = L + d * DS; float acc[16];
#pragma unroll
          for (int hp = 0; hp < 16; ++hp) acc[hp] = 0.f;
#pragma unroll 4
          for (int p = 0; p < 64; ++p) { const float pr = D[p * 34 + 2 * k], pi = D[p * 34 + 2 * k + 1], cr = D[4224 + h * 64 + p], ci = D[5248 + h * 64 + p]; const float wr = cr * pr - ci * pi, wi = cr * pi + ci * pr;
#pragma unroll
              for (int q4 = 0; q4 < 4; ++q4) { const f32x4 br = *(const LAS f32x4*)(D + 2176 + p * 16 + 4 * q4), bi = *(const LAS f32x4*)(D + 3200 + p * 16 + 4 * q4);
#pragma unroll
                  for (int e = 0; e < 4; ++e) acc[4 * q4 + e] += wr * br[e] - wi * bi[e]; } }
          if (k == 0 && d == 1) {
#pragma unroll
              for (int hp = 0; hp < 16; ++hp) L[2 * DS + h * 16 + hp] = acc[hp]; }
          WG_BAR();
          if (k == 0 && d == 0) { const float dsk = a.in[I_SD][l * SSM_W + g * 16 + h];
#pragma unroll
              for (int hp = 0; hp < 16; ++hp) acc[hp] += L[2 * DS + h * 16 + hp] + (hp == h ? dsk : 0.f); }
          if (!(k == 0 && d == 1)) { const int li = d == 0 ? 15 + k : 15 - k; v4u w0, w1;
              w0.x = pk2(acc[0], acc[1]); w0.y = pk2(acc[2], acc[3]); w0.z = pk2(acc[4], acc[5]); w0.w = pk2(acc[6], acc[7]); w1.x = pk2(acc[8], acc[9]); w1.y = pk2(acc[10], acc[11]); w1.z = pk2(acc[12], acc[13]); w1.w = pk2(acc[14], acc[15]);
              v4u* o = (v4u*)(KL + (((size_t)lg * 31 + li) * 16 + h) * 16); o[0] = w0; o[1] = w1; } }
#pragma unroll 1
        for (int e8 = F.tid; e8 < 8192; e8 += NWAVES * 64) { unsigned pw[4], ew[4];
#pragma unroll
            for (int j = 0; j < 4; ++j) { float pv[2], ev[2];
#pragma unroll
                for (int u = 0; u < 2; ++u) { const int idx = e8 * 8 + 2 * j + u;
                    { const int kk = idx & 255, tp = kk >> 4, hp = kk & 15, s = idx >> 8, d = s >> 7, p = (s >> 1) & 63, ri = s & 1; const LAS float* D = L + d * DS; const int k = d ? tp : 15 - tp;
                      const float pr = D[p * 34 + 2 * k], pi = D[p * 34 + 2 * k + 1], br = D[2176 + p * 16 + hp], bi = D[3200 + p * 16 + hp]; pv[u] = ri ? pr * bi + pi * br : pr * br - pi * bi; }
                    { const int s = idx & 255, d = s >> 7, p = (s >> 1) & 63, ri = s & 1, th = idx >> 8, t = th >> 4, h = th & 15; const LAS float* D = L + d * DS; const int k = d ? 16 - t : t + 1;
                      const float pr = D[p * 34 + 2 * k], pi = D[p * 34 + 2 * k + 1], cr = D[4224 + h * 64 + p], ci = D[5248 + h * 64 + p]; ev[u] = ri ? -(cr * pi + ci * pr) : cr * pr - ci * pi; } }
                pw[j] = pk2(pv[0], pv[1]); ew[j] = pk2(ev[0], ev[1]); }
            *(v4u*)(PT + (size_t)lg * 65536 + e8 * 8) = (v4u){pw[0], pw[1], pw[2], pw[3]}; *(v4u*)(ET + (size_t)lg * 65536 + e8 * 8) = (v4u){ew[0], ew[1], ew[2], ew[3]}; }
        WG_BAR();
    }
}
__device__ __forceinline__ void s5_stage_u(const Frame& F, const bf16* Z, int g, int c0, int nc, LAS unsigned char* dst) {
    v4u w[8];
#pragma unroll
    for (int j = 0; j < 8; ++j) { const int p0 = F.tid + j * NWAVES * 64, p = p0 < nc * 32 ? p0 : nc * 32 - 1; const int r = p >> 1, hf = p & 1; w[j] = *(const v4u*)(Z + (size_t)(c0 * 16 + r) * N_IN + OFF_S + g * 16 + hf * 8); }
#pragma unroll
    for (int j = 0; j < 8; ++j) { const int p = F.tid + j * NWAVES * 64; if (p < nc * 32) { const int r = p >> 1, hf = p & 1; *(LAS v4u*)(dst + (r >> 4) * 528 + (r & 15) * 32 + hf * 16) = w[j]; } }
}
__device__ __forceinline__ void s5_chunk_states(const Frame& F, const Args& a, int l) {
    const bf16* Z = (const bf16*)(a.ws + WS_Z); const bf16* PT = (const bf16*)(a.ws + WS_PT); float* CS = (float*)(a.ws + WS_CS);
    const int n16 = F.lane & 15, kq = F.lane >> 4; LAS unsigned char* UL = F.lds + RING_OFF;
#pragma unroll 1
    for (int it = F.bid; it < 384; it += F.G) {
        const bool lat = it < 256; const int v_ = lat ? it : it - 256, j_ = v_ >> 3; const int g = 4 * (v_ & 7) + (j_ & 3), c0 = lat ? 128 * (j_ >> 2) : 1024 + 16 * (j_ >> 2), nct = lat ? 8 : 1;        const int lg = l * 32 + g;
        s5_stage_u(F, Z, g, c0, nct * 16, UL); asm volatile("" ::: "memory");
        bf16x8_t af[2][8];
#pragma unroll
        for (int q = 0; q < 2; ++q)
#pragma unroll
            for (int ks = 0; ks < 8; ++ks) af[q][ks] = *(const bf16x8_t*)(PT + ((size_t)lg * 256 + 32 * F.wave + 16 * q + n16) * 256 + 32 * ks + 8 * kq);
        WG_BAR();
#pragma unroll 2
        for (int ct = 0; ct < nct; ++ct) { const int chunk = c0 + 16 * ct + n16; bf16x8_t bfr[8];
#pragma unroll
            for (int ks = 0; ks < 8; ++ks) bfr[ks] = *(const LAS bf16x8_t*)(UL + (16 * ct + n16) * 528 + (2 * ks + (kq >> 1)) * 32 + (kq & 1) * 16);
            f32x4 acc0 = (f32x4){0.f, 0.f, 0.f, 0.f}, acc1 = acc0;
#pragma unroll
            for (int ks = 0; ks < 8; ++ks) { acc0 = __builtin_amdgcn_mfma_f32_16x16x32_bf16(af[0][ks], bfr[ks], acc0, 0, 0, 0); acc1 = __builtin_amdgcn_mfma_f32_16x16x32_bf16(af[1][ks], bfr[ks], acc1, 0, 0, 0); }
            float* o = CS + ((size_t)chunk * 32 + g) * 256 + 32 * F.wave + 4 * kq; *(f32x4*)o = acc0; *(f32x4*)(o + 16) = acc1; }
        WG_BAR();
    }
}
__device__ __forceinline__ void s5_carries(const Frame& F, const Args& a, int l) {
    const float* CS = (const float*)(a.ws + WS_CS); unsigned* CY = (unsigned*)(a.ws + WS_CY); const float* AP = (const float*)(a.ws + WS_APOW);
    const bool remap = F.G == 256;
    for (int ci = remap ? (F.bid < 120 && F.wave < 3 ? F.wave * 120 + F.bid : 256) : F.gws; ci < 256; ci += remap ? 256 : F.NGW) {
        const int dir = ci & 1, g = (ci >> 1) & 31, b = ci >> 6; const int i = ((l * 2 + dir) * 32 + g) * 64 + F.lane;
        const float ar = AP[((size_t)i * 17 + 16) * 2], ai = AP[((size_t)i * 17 + 16) * 2 + 1]; float hr = 0.f, hi = 0.f;
        const size_t lane_off = (size_t)g * 256 + dir * 128 + 2 * F.lane;
#define S5_CIDX(step) ((step) < 16 ? 1024 + 16 * b + (dir ? 15 - (step) : (step)) : 256 * b + (dir ? 271 - (step) : (step) - 16))
        f32x2 sa[34], sb[34];
#pragma unroll
        for (int j = 0; j < 34; ++j) sa[j] = *(const f32x2*)(CS + (size_t)S5_CIDX(j) * 8192 + lane_off);
#pragma unroll 1
        for (int s0 = 0; s0 < 272; s0 += 68) {
#pragma unroll
            for (int j = 0; j < 34; ++j) sb[j] = *(const f32x2*)(CS + (size_t)S5_CIDX(s0 + 34 + j) * 8192 + lane_off);
#pragma unroll
            for (int j = 0; j < 34; ++j) { CY[((size_t)S5_CIDX(s0 + j) * 8192 + lane_off) >> 1] = pk2(hr, hi); const float nr = ar * hr - ai * hi + sa[j].x, ni = ar * hi + ai * hr + sa[j].y; hr = nr; hi = ni; }
            if (s0 + 68 < 272) {
#pragma unroll
                for (int j = 0; j < 34; ++j) sa[j] = *(const f32x2*)(CS + (size_t)S5_CIDX(s0 + 68 + j) * 8192 + lane_off); }
#pragma unroll
            for (int j = 0; j < 34; ++j) { CY[((size_t)S5_CIDX(s0 + 34 + j) * 8192 + lane_off) >> 1] = pk2(hr, hi); const float nr = ar * hr - ai * hi + sb[j].x, ni = ar * hi + ai * hr + sb[j].y; hr = nr; hi = ni; }
        }
#undef S5_CIDX
    }
}
__device__ __forceinline__ void s5_outputs(const Frame& F, const Args& a, int l, bool with_ctx) {
    const bf16* Z = (const bf16*)(a.ws + WS_Z); const bf16* KL = (const bf16*)(a.ws + WS_KL); const bf16* ET = (const bf16*)(a.ws + WS_ET); const bf16* CY = (const bf16*)(a.ws + WS_CY); bf16* GS = (bf16*)(a.ws + WS_GS);
    const int n16 = F.lane & 15, kq = F.lane >> 4; const int NI = with_ctx ? 384 : 256; LAS unsigned char* UL = F.lds + RING_OFF; LAS unsigned char* CL = UL + 128 * 528;
#pragma unroll 1
    for (int it = F.bid; it < NI; it += F.G) {
        const bool lat = it < 256; const int v_ = lat ? it : it - 256, j_ = v_ >> 3; const int g = 4 * (v_ & 7) + (j_ & 3), c0 = lat ? 128 * (j_ >> 2) : 1024 + 16 * (j_ >> 2), nct = lat ? 8 : 1;        const int lg = l * 32 + g;
        s5_stage_u(F, Z, g, c0, nct * 16, UL);
        { v4u w[8];
#pragma unroll
          for (int j = 0; j < 8; ++j) { const int p0 = F.tid + j * NWAVES * 64, p = p0 < nct * 16 * 32 ? p0 : nct * 16 * 32 - 1; const int c = p >> 5, pc = p & 31; w[j] = *(const v4u*)(CY + ((size_t)(c0 + c) * 32 + g) * 256 + pc * 8); }
#pragma unroll
          for (int j = 0; j < 8; ++j) { const int p = F.tid + j * NWAVES * 64; if (p < nct * 16 * 32) { const int c = p >> 5, pc = p & 31; *(LAS v4u*)(CL + c * 528 + pc * 16) = w[j]; } } }
        asm volatile("" ::: "memory");
        bf16x8_t af[2][16];
#pragma unroll
        for (int q = 0; q < 2; ++q) { const int t = 2 * F.wave + q;
#pragma unroll
            for (int ks = 0; ks < 8; ++ks) { const int tp = 2 * ks + (kq >> 1); af[q][ks] = *(const bf16x8_t*)(KL + (((size_t)lg * 31 + (t - tp + 15)) * 16 + n16) * 16 + 8 * (kq & 1)); }
#pragma unroll
            for (int ks = 0; ks < 8; ++ks) af[q][8 + ks] = *(const bf16x8_t*)(ET + ((size_t)lg * 256 + t * 16 + n16) * 256 + 32 * ks + 8 * kq); }
        WG_BAR();
#pragma unroll 1
        for (int ct = 0; ct < nct; ++ct) { const int chunk = c0 + 16 * ct + n16; bf16x8_t bfr[16];
#pragma unroll
            for (int ks = 0; ks < 8; ++ks) bfr[ks] = *(const LAS bf16x8_t*)(UL + (16 * ct + n16) * 528 + (2 * ks + (kq >> 1)) * 32 + (kq & 1) * 16);
#pragma unroll
            for (int ks = 0; ks < 8; ++ks) bfr[8 + ks] = *(const LAS bf16x8_t*)(CL + (16 * ct + n16) * 528 + ks * 64 + kq * 16);
            f32x4 acc0 = (f32x4){0.f, 0.f, 0.f, 0.f}, acc1 = acc0;
#pragma unroll
            for (int ks = 0; ks < 16; ++ks) { acc0 = __builtin_amdgcn_mfma_f32_16x16x32_bf16(af[0][ks], bfr[ks], acc0, 0, 0, 0); acc1 = __builtin_amdgcn_mfma_f32_16x16x32_bf16(af[1][ks], bfr[ks], acc1, 0, 0, 0); }
            { const size_t r0 = (size_t)(chunk * 16 + 2 * F.wave); v2u w0, w1;
              w0.x = pk2(gelu_tanh(acc0[0]), gelu_tanh(acc0[1])); w0.y = pk2(gelu_tanh(acc0[2]), gelu_tanh(acc0[3])); w1.x = pk2(gelu_tanh(acc1[0]), gelu_tanh(acc1[1])); w1.y = pk2(gelu_tanh(acc1[2]), gelu_tanh(acc1[3]));
              *(v2u*)(GS + r0 * SSM_W + g * 16 + 4 * kq) = w0; *(v2u*)(GS + (r0 + 1) * SSM_W + g * 16 + 4 * kq) = w1; }
        }
        WG_BAR();
    }
}
__device__ __forceinline__ void gmlp_phase(const Frame& F, const Args& a, int l, bool with_ctx) {
    const bf16* Z = (const bf16*)(a.ws + WS_Z); bf16* CAT = (bf16*)(a.ws + WS_CAT); const bf16* WSB = (const bf16*)(a.ws + WS_WSB) + (size_t)l * 4 * 128 * 128;
    const float* lg = a.in[I_LNG] + l * GMLP_W; const float* lb = a.in[I_LNB] + l * GMLP_W; const float* bs = a.in[I_BS] + l * 512;
    constexpr int RS = 1056; const int n16 = F.lane & 15, kq = F.lane >> 4, q4 = (F.lane & 15) >> 2, p4 = F.lane & 3;
    const unsigned lds0 = (unsigned)(uintptr_t)(F.lds + RING_OFF);
    const int NU = with_ctx ? 136 : 128;
    float lgv[8], lbv[8];
#pragma unroll
    for (int j = 0; j < 8; ++j) { lgv[j] = lg[8 * F.lane + j]; lbv[j] = lb[8 * F.lane + j]; }
#pragma unroll 1
    for (int u = F.G - 1 - F.bid; u < NU; u += F.G) {
        const int rb = u * 128;
        v4u wrow[16];
#pragma unroll
        for (int jj = 0; jj < 16; ++jj) wrow[jj] = *(const v4u*)(Z + (size_t)(rb + 16 * F.wave + jj) * N_IN + OFF_GV + 8 * F.lane);
#pragma unroll
        for (int jj = 0; jj < 16; ++jj) { const int j = 16 * F.wave + jj;
            const v4u w = wrow[jj]; float e[8];
            e[0] = gelu_tanh(bflo(w.x)); e[1] = gelu_tanh(bfhi(w.x)); e[2] = gelu_tanh(bflo(w.y)); e[3] = gelu_tanh(bfhi(w.y)); e[4] = gelu_tanh(bflo(w.z)); e[5] = gelu_tanh(bfhi(w.z)); e[6] = gelu_tanh(bflo(w.w)); e[7] = gelu_tanh(bfhi(w.w));
            float s = 0.f;
#pragma unroll
            for (int k = 0; k < 8; ++k) s += e[k];
            const float mu = wave_sum(s) * (1.f / GMLP_W); float qq = 0.f;
#pragma unroll
            for (int k = 0; k < 8; ++k) { e[k] -= mu; qq += e[k] * e[k]; }
            const float rstd = __builtin_amdgcn_rsqf(wave_sum(qq) * (1.f / GMLP_W) + NORM_EPS);
#pragma unroll
            for (int k = 0; k < 8; ++k) e[k] = e[k] * rstd * lgv[k] + lbv[k];
            v4u o; o.x = pk2(e[0], e[1]); o.y = pk2(e[2], e[3]); o.z = pk2(e[4], e[5]); o.w = pk2(e[6], e[7]);
            *(LAS v4u*)(F.lds + RING_OFF + j * RS + 16 * F.lane) = o; }
        asm volatile("s_waitcnt lgkmcnt(0)\n\ts_barrier" ::: "memory");
#pragma unroll 1
        for (int g = 0; g < 4; ++g) {
            bf16x8_t af[4];
#pragma unroll
            for (int ks = 0; ks < 4; ++ks) af[ks] = *(const bf16x8_t*)(WSB + ((size_t)g * 128 + 16 * F.wave + n16) * 128 + 32 * ks + 8 * kq);
            const float bsv = bs[g * 128 + 16 * F.wave + n16];
            v2u guv[8];
#pragma unroll
            for (int c8 = 0; c8 < 8; ++c8) guv[c8] = *(const v2u*)(Z + (size_t)(rb + 16 * F.wave + n16) * N_IN + OFF_GU + 16 * (g * 8 + c8) + 4 * kq);
#pragma unroll
            for (int c8 = 0; c8 < 8; ++c8) { const int ct = g * 8 + c8;
                const unsigned ab = lds0 + RS * (8 * kq + q4) + 32 * ct + 8 * p4;
                typedef short s16x4_t __attribute__((ext_vector_type(4))); s16x4_t t0[4], t1[4];
#pragma unroll
                for (int ks = 0; ks < 4; ++ks) { asm volatile("ds_read_b64_tr_b16 %0, %1" : "=&v"(t0[ks]) : "v"(ab + RS * 32 * ks) : "memory"); asm volatile("ds_read_b64_tr_b16 %0, %1" : "=&v"(t1[ks]) : "v"(ab + RS * (32 * ks + 4)) : "memory"); }
                asm volatile("s_waitcnt lgkmcnt(0)" ::: "memory"); __builtin_amdgcn_sched_barrier(0);
                f32x4 acc = (f32x4){0.f, 0.f, 0.f, 0.f};
#pragma unroll
                for (int ks = 0; ks < 4; ++ks) { const bf16x8_t bfr = (bf16x8_t){t0[ks][0], t0[ks][1], t0[ks][2], t0[ks][3], t1[ks][0], t1[ks][1], t1[ks][2], t1[ks][3]}; acc = __builtin_amdgcn_mfma_f32_16x16x32_bf16(bfr, af[ks], acc, 0, 0, 0); }
                { const size_t row = (size_t)(rb + 16 * F.wave + n16); const v2u gw = guv[c8];
                  const float o0 = gelu_tanh(__uint_as_float(gw.x << 16)) * (acc[0] + bsv), o1 = gelu_tanh(__uint_as_float(gw.x & 0xffff0000u)) * (acc[1] + bsv), o2 = gelu_tanh(__uint_as_float(gw.y << 16)) * (acc[2] + bsv), o3 = gelu_tanh(__uint_as_float(gw.y & 0xffff0000u)) * (acc[3] + bsv);
                  v2u w; w.x = pk2(o0, o1); w.y = pk2(o2, o3); *(v2u*)(CAT + row * DM + 1536 + 16 * ct + 4 * kq) = w; }
            }
        }
        asm volatile("s_waitcnt lgkmcnt(0)\n\ts_barrier" ::: "memory");
    }
}


namespace pg8 {
__device__ __forceinline__ void rstd_table(const float* ssq, int pm, PG8_LAS float* rt, int tid) {
    if (tid < 256) { const f32x4* p = (const f32x4*)(ssq + (size_t)(pm * BM + tid) * 32); f32x4 s = p[0];
#pragma unroll
        for (int j = 1; j < 8; ++j) s = s + p[j];
        rt[tid] = __builtin_amdgcn_rsqf(((s[0] + s[1]) + (s[2] + s[3])) * (1.f / 2048.f) + 1e-6f); }
    asm volatile("s_waitcnt lgkmcnt(0)\n\ts_barrier" ::: "memory");
}
struct EpiIn {
    static constexpr bool PERM = true, AFTER_DRAIN = false, PERM_A = false;
    bf16_t* Z; const float* rstd_; const float* shw; const PG8_LAS float* rtab;
    __device__ __forceinline__ void operator()(const f32x4 (&acc)[2][2][4][2], const Unit& u, int wr, int wc, int fr, int fq) const {
        const bool lat = u.pm < 64, ropeq = u.pn < 4, ropek = u.pn == 4; const int mrow = lat ? (u.pm >> 4) : 4;
        const int col0 = u.pn * BM + wc * 32 + 8 * fq;
        f32x4 sh[2][2];
#pragma unroll
        for (int bj = 0; bj < 2; ++bj)
#pragma unroll
            for (int n = 0; n < 2; ++n) sh[bj][n] = *(const f32x4*)(shw + (size_t)mrow * (2816 + 11264) + col0 + bj * HALF + 4 * n);
        const float C2 = 0.125f * 1.4426950408889634f;
        if (!(lat && (ropeq || ropek))) {
            const float qs = ropeq ? C2 : 1.f;
#pragma unroll
            for (int ai = 0; ai < 2; ++ai)
#pragma unroll
                for (int m = 0; m < 4; ++m) { const size_t row = (size_t)u.pm * BM + ai * HALF + wr * 64 + m * 16 + fr; const float rq = rstd_[row] * qs;
#pragma unroll
                    for (int bj = 0; bj < 2; ++bj) { const f32x4 v0 = acc[ai][bj][m][0] * rq + sh[bj][0] * qs, v1 = acc[ai][bj][m][1] * rq + sh[bj][1] * qs;
                        u32x4 w; w.x = cvt_pk_bf16(v0[0], v0[1]); w.y = cvt_pk_bf16(v0[2], v0[3]); w.z = cvt_pk_bf16(v1[0], v1[1]); w.w = cvt_pk_bf16(v1[2], v1[3]);
                        *(u32x4*)(Z + row * 2816 + col0 + bj * HALF) = w; } }
        } else {
#pragma unroll
        for (int ai = 0; ai < 2; ++ai)
#pragma unroll
            for (int m = 0; m < 4; ++m) { const int r = ai * HALF + wr * 64 + m * 16 + fr; const size_t row = (size_t)u.pm * BM + r; const float rstd = rstd_[row];
                const int t = (int)(row & 4095); const PG8_LAS float* tp = rtab + ((wc & 1) ? (t & 63) : (t >> 6)) * 36 + (wc & 1) * 16 + 8 * (fq & 1) + 4 * (fq >> 1);
                const f32x4 cc = *(const PG8_LAS f32x4*)tp, ss = *(const PG8_LAS f32x4*)(tp + 64 * 36);
#pragma unroll
                for (int bj = 0; bj < 2; ++bj) { f32x4 v0 = acc[ai][bj][m][0] * rstd + sh[bj][0], v1 = acc[ai][bj][m][1] * rstd + sh[bj][1];
                    if (ropeq || bj == 0) {
#pragma unroll
                        for (int i = 0; i < 4; ++i) { auto a = __builtin_amdgcn_permlane32_swap(__float_as_uint(v0[i]), __float_as_uint(v1[i]), false, false);
                            const float x1 = __uint_as_float(a[0]), x2 = __uint_as_float(a[1]); const float o1 = x1 * cc[i] - x2 * ss[i], o2 = x1 * ss[i] + x2 * cc[i];
                            auto b = __builtin_amdgcn_permlane32_swap(__float_as_uint(o1), __float_as_uint(o2), false, false); v0[i] = __uint_as_float(b[0]); v1[i] = __uint_as_float(b[1]); } }
                    if (ropeq) { v0 = v0 * C2; v1 = v1 * C2; }
                    u32x4 w; w.x = cvt_pk_bf16(v0[0], v0[1]); w.y = cvt_pk_bf16(v0[2], v0[3]); w.z = cvt_pk_bf16(v1[0], v1[1]); w.w = cvt_pk_bf16(v1[2], v1[3]);
                    *(u32x4*)(Z + row * 2816 + col0 + bj * HALF) = w; } }
        }
    }
};
struct EpiUpConv {
    static constexpr bool PERM = false, AFTER_DRAIN = false, PERM_A = true;
    bf16_t* ACT; const float* rstd_; const float* shw; const float* cw; const float* cb; float* EG; float* EV; PG8_LAS float* edg;
    __device__ __forceinline__ void operator()(const f32x4 (&acc)[2][2][4][2], const Unit& u, int wr, int wc, int fr, int fq) const {
        const int mrow = u.pm < 64 ? (u.pm >> 4) : 4; const int colg = u.pn * BM + wc * 32 + 4 * fq, cl = wc * 32 + 4 * fq, cg0 = u.pn * HALF + cl;
        f32x4 shg[2], shv[2], w0[2], w1[2], w2[2], bb[2];
#pragma unroll
        for (int n = 0; n < 2; ++n) { shg[n] = *(const f32x4*)(shw + (size_t)mrow * (2816 + 11264) + colg + 16 * n); shv[n] = *(const f32x4*)(shw + (size_t)mrow * (2816 + 11264) + colg + HALF + 16 * n);
            w0[n] = *(const f32x4*)(cw + cg0 + 16 * n); w1[n] = *(const f32x4*)(cw + 5632 + cg0 + 16 * n); w2[n] = *(const f32x4*)(cw + 2 * 5632 + cg0 + 16 * n); bb[n] = *(const f32x4*)(cb + cg0 + 16 * n); }
        f32x4 g[2][4][2], v[2][4][2];
#pragma unroll
        for (int ai = 0; ai < 2; ++ai) { const f32x4 rs4 = *(const f32x4*)(rstd_ + (size_t)u.pm * BM + ai * HALF + wr * 64 + 4 * fr);
#pragma unroll
            for (int m = 0; m < 4; ++m)
#pragma unroll
                for (int n = 0; n < 2; ++n) { g[ai][m][n] = acc[ai][0][m][n] * rs4[m] + shg[n]; v[ai][m][n] = acc[ai][1][m][n] * rs4[m] + shv[n]; } }
#pragma unroll
        for (int ai = 0; ai < 2; ++ai) { const int blk = 2 * ai + wr;
            if (fr == 0 && blk > 0) {
#pragma unroll
                for (int n = 0; n < 2; ++n) *(PG8_LAS f32x4*)(edg + (2 * blk - 1) * 128 + cl + 16 * n) = g[ai][0][n]; }
            if (fr == 15 && blk < 3) {
#pragma unroll
                for (int n = 0; n < 2; ++n) *(PG8_LAS f32x4*)(edg + (2 * blk) * 128 + cl + 16 * n) = g[ai][3][n]; } }
        { float* eg = EG + ((size_t)(u.pm * 44 + u.pn) * 4) * 128 + cl; float* ev = EV + ((size_t)(u.pm * 44 + u.pn) * 2) * 128 + cl;
          if (wr == 0 && fr == 0) {
#pragma unroll
              for (int n = 0; n < 2; ++n) { *(f32x4*)(eg + 16 * n) = g[0][0][n]; *(f32x4*)(eg + 128 + 16 * n) = g[0][1][n]; *(f32x4*)(ev + 16 * n) = v[0][0][n]; } }
          if (wr == 1 && fr == 15) {
#pragma unroll
              for (int n = 0; n < 2; ++n) { *(f32x4*)(eg + 2 * 128 + 16 * n) = g[1][2][n]; *(f32x4*)(eg + 3 * 128 + 16 * n) = g[1][3][n]; *(f32x4*)(ev + 128 + 16 * n) = v[1][3][n]; } } }
        asm volatile("s_waitcnt lgkmcnt(0)\n\ts_barrier" ::: "memory");
#pragma unroll
        for (int ai = 0; ai < 2; ++ai) { const int blk = 2 * ai + wr; unsigned wres[2][4][2];
#pragma unroll
            for (int n = 0; n < 2; ++n) { f32x4 top = {0.f, 0.f, 0.f, 0.f}, bot = top;
                if (blk > 0) top = *(const PG8_LAS f32x4*)(edg + (2 * (blk - 1)) * 128 + cl + 16 * n);
                if (blk < 3) bot = *(const PG8_LAS f32x4*)(edg + (2 * (blk + 1) - 1) * 128 + cl + 16 * n);
                f32x4 upv, dnv;
#pragma unroll
                for (int i = 0; i < 4; ++i) { upv[i] = __int_as_float(__builtin_amdgcn_update_dpp(__float_as_int(top[i]), __float_as_int(g[ai][3][n][i]), 0x111, 0xf, 0xf, false));
                                              dnv[i] = __int_as_float(__builtin_amdgcn_update_dpp(__float_as_int(bot[i]), __float_as_int(g[ai][0][n][i]), 0x101, 0xf, 0xf, false)); }
#pragma unroll
                for (int m = 0; m < 4; ++m) { const f32x4 up = m == 0 ? upv : g[ai][m == 0 ? 0 : m - 1][n], dn = m == 3 ? dnv : g[ai][m == 3 ? 3 : m + 1][n]; f32x4 o;
                    const f32x4 pre = __builtin_elementwise_fma(w0[n], up, __builtin_elementwise_fma(w1[n], g[ai][m][n], __builtin_elementwise_fma(w2[n], dn, bb[n])));
                    const f32x4 ea = pre * -1.4426950408889634f, pvv = pre * v[ai][m][n]; f32x4 den;
#pragma unroll
                    for (int i = 0; i < 4; ++i) den[i] = __builtin_amdgcn_exp2f(ea[i]);
                    den = den + 1.f;
#pragma unroll
                    for (int i = 0; i < 4; ++i) den[i] = __builtin_amdgcn_rcpf(den[i]);
                    o = pvv * den;
                    wres[n][m][0] = cvt_pk_bf16(o[0], o[1]); wres[n][m][1] = cvt_pk_bf16(o[2], o[3]); } }
            { const bool hi = fr >= 8; const int tr0 = u.pm * BM + ai * HALF + wr * 64 + 4 * (fr & 7);
              char* lb = (char*)ACT + (size_t)(tr0 >> 1) * (4 * 5632) + (size_t)(u.pn * 4 + wc) * 128 + (hi ? 64 : 0) + 16 * fq;
#pragma unroll
              for (int mp = 0; mp < 2; ++mp) { u32x4 p0 = {wres[0][2 * mp][0], wres[0][2 * mp][1], wres[1][2 * mp][0], wres[1][2 * mp][1]}, p1 = {wres[0][2 * mp + 1][0], wres[0][2 * mp + 1][1], wres[1][2 * mp + 1][0], wres[1][2 * mp + 1][1]}, rv;
#pragma unroll
                  for (int i = 0; i < 4; ++i) { const unsigned sd = hi ? p0[i] : p1[i]; rv[i] = (unsigned)__builtin_amdgcn_update_dpp(0, (int)sd, 0x128, 0xf, 0xf, false); }
                  u32x4 s1, s2;
#pragma unroll
                  for (int i = 0; i < 4; ++i) { s1[i] = hi ? rv[i] : p0[i]; s2[i] = hi ? p1[i] : rv[i]; }
                  *(u32x4*)(lb + (size_t)mp * (4 * 5632)) = s1; *(u32x4*)(lb + (size_t)(16 + mp) * (4 * 5632)) = s2; } } }
    }
};
struct EpiRes {
    static constexpr bool PERM = false, AFTER_DRAIN = false, PERM_A = false;
    float* X; const float* Xr; const float* Xrc; const float* gate; const float* gsn; bf16_t* An; float* ssq;
    __device__ __forceinline__ void operator()(const f32x4 (&acc)[2][2][4][2], const Unit& u, int wr, int wc, int fr, int fq) const {
        typedef unsigned u32x2_t __attribute__((ext_vector_type(2)));
        const bool hi = fr >= 8;
        const int row0 = u.pm * BM + wr * 64 + (fr & 7), col0 = u.pn * BM + wc * 32 + (hi ? 16 : 0) + 4 * fq; const int mrow = u.pm < 64 ? (u.pm >> 4) : 4;
        f32x4 gv[2], sv[2];
#pragma unroll
        for (int bj = 0; bj < 2; ++bj) { gv[bj] = *(const f32x4*)(gate + (size_t)mrow * (6 * 2048) + col0 + bj * HALF); sv[bj] = gsn ? *(const f32x4*)(gsn + (size_t)mrow * 2048 + col0 + bj * HALF) : (f32x4){0.f, 0.f, 0.f, 0.f}; }
#pragma unroll
        for (int ai = 0; ai < 2; ++ai)
#pragma unroll
            for (int mp = 0; mp < 2; ++mp) { f32x4 xin[2][2][2];
#pragma unroll
                for (int mm = 0; mm < 2; ++mm) { const size_t row = (size_t)(row0 + ai * HALF + (2 * mp + mm) * 16); const float* rowr = (u.pm < 64 ? Xr : Xrc) + row * 2048 + col0;
#pragma unroll
                    for (int bj = 0; bj < 2; ++bj)
#pragma unroll
                        for (int j = 0; j < 2; ++j) xin[mm][bj][j] = *(const f32x4*)(rowr + (size_t)j * 8 * 2048 + bj * HALF); }
#pragma unroll
                for (int mm = 0; mm < 2; ++mm) { const int m = 2 * mp + mm; const size_t row = (size_t)(row0 + ai * HALF + m * 16); float* rowp = X + row * 2048 + col0; float q0 = 0.f, q1 = 0.f; u32x4 wa0 = {0u, 0u, 0u, 0u}, wa1 = {0u, 0u, 0u, 0u};
#pragma unroll
                    for (int bj = 0; bj < 2; ++bj) { const f32x4 a0 = acc[ai][bj][m][0], a1 = acc[ai][bj][m][1]; f32x4 rv;
#pragma unroll
                        for (int i = 0; i < 4; ++i) { const float sd = hi ? a0[i] : a1[i]; rv[i] = __int_as_float(__builtin_amdgcn_update_dpp(0, __float_as_int(sd), 0x128, 0xf, 0xf, false)); }
                        f32x4 s0, s1;
#pragma unroll
                        for (int i = 0; i < 4; ++i) { s0[i] = hi ? rv[i] : a0[i]; s1[i] = hi ? a1[i] : rv[i]; }
                        const f32x4 x0 = xin[mm][bj][0] + gv[bj] * s0, x1 = xin[mm][bj][1] + gv[bj] * s1;
                        *(f32x4*)(rowp + bj * HALF) = x0; *(f32x4*)(rowp + (size_t)8 * 2048 + bj * HALF) = x1;
                        q0 += (x0[0] * x0[0] + x0[1] * x0[1]) + (x0[2] * x0[2] + x0[3] * x0[3]); q1 += (x1[0] * x1[0] + x1[1] * x1[1]) + (x1[2] * x1[2] + x1[3] * x1[3]);
                        if (gsn) { const f32x4 y0 = x0 * sv[bj], y1 = x1 * sv[bj]; wa0[2 * bj] = cvt_pk_bf16(y0[0], y0[1]); wa0[2 * bj + 1] = cvt_pk_bf16(y0[2], y0[3]); wa1[2 * bj] = cvt_pk_bf16(y1[0], y1[1]); wa1[2 * bj + 1] = cvt_pk_bf16(y1[2], y1[3]); } }
                    if (gsn) { bf16_t* ap = An + row * 2048 + u.pn * BM + 64 * wc + (hi ? 32 : 0) + 8 * fq;
                        *(u32x4*)ap = wa0; *(u32x4*)(ap + (size_t)8 * 2048) = wa1; }
                    if (gsn) {
                        { auto r_ = __builtin_amdgcn_permlane16_swap(__float_as_uint(q0), __float_as_uint(q0), false, false); q0 = __uint_as_float(r_[0]) + __uint_as_float(r_[1]); }
                        { auto r_ = __builtin_amdgcn_permlane32_swap(__float_as_uint(q0), __float_as_uint(q0), false, false); q0 = __uint_as_float(r_[0]) + __uint_as_float(r_[1]); }
                        { auto r_ = __builtin_amdgcn_permlane16_swap(__float_as_uint(q1), __float_as_uint(q1), false, false); q1 = __uint_as_float(r_[0]) + __uint_as_float(r_[1]); }
                        { auto r_ = __builtin_amdgcn_permlane32_swap(__float_as_uint(q1), __float_as_uint(q1), false, false); q1 = __uint_as_float(r_[0]) + __uint_as_float(r_[1]); }
                        q0 += __int_as_float(__builtin_amdgcn_update_dpp(0, __float_as_int(q0), 0x128, 0xf, 0xf, false)); q1 += __int_as_float(__builtin_amdgcn_update_dpp(0, __float_as_int(q1), 0x128, 0xf, 0xf, false));
                        if (fq == 0 && !hi) { ssq[row * 32 + u.pn * 4 + wc] = q0; ssq[(row + 8) * 32 + u.pn * 4 + wc] = q1; } } } }
    }
};
struct PieceOrder {
    int c0, G, np, nks, klen_b, uneven;
    __device__ __forceinline__ bool next(int i, Unit& u) const { const int c = c0 + i * G; if (c >= np) return false; const int ks = c % nks, t = c / nks; u.pn = t & 7; u.pm = 64 + (t >> 3); u.aux = ks;
        if (uneven) { u.kb = (11 * ks - (ks & 1)) * 128; u.nt = 10 + 2 * (ks & 1); } else { u.kb = ks * klen_b; u.nt = 0; } return true; }
    __device__ __forceinline__ void a_ready(const Unit&) const {}
    __device__ __forceinline__ void done(const Unit&) const {}
};
struct EpiSlab {
    static constexpr bool PERM = false, AFTER_DRAIN = false, PERM_A = false;
    float* S;
    __device__ __forceinline__ void operator()(const f32x4 (&acc)[2][2][4][2], const Unit& u, int wr, int wc, int fr, int fq) const {
        float* base = S + ((size_t)u.aux * 1024 + (size_t)(u.pm - 64) * BM + wr * 64 + fr) * 2048 + u.pn * BM + wc * 32 + 4 * fq;
#pragma unroll
        for (int ai = 0; ai < 2; ++ai)
#pragma unroll
            for (int m = 0; m < 4; ++m)
#pragma unroll
                for (int bj = 0; bj < 2; ++bj)
#pragma unroll
                    for (int n = 0; n < 2; ++n) *(f32x4*)(base + (size_t)(ai * HALF + m * 16) * 2048 + bj * HALF + n * 16) = acc[ai][bj][m][n];
    }
};
struct EpiNone { static constexpr bool PERM = false, AFTER_DRAIN = false, PERM_A = false; float* sink;
    __device__ __forceinline__ void operator()(const f32x4 (&acc)[2][2][4][2], const Unit& u, int wr, int wc, int fr, int fq) const { f32x4 s = acc[0][0][0][0];
#pragma unroll
        for (int a = 0; a < 2; ++a)
#pragma unroll
            for (int b = 0; b < 2; ++b)
#pragma unroll
                for (int m = 0; m < 4; ++m)
#pragma unroll
                    for (int n = 0; n < 2; ++n) s = s + acc[a][b][m][n];
        if (s[0] + s[1] + s[2] + s[3] == 1.2345e-33f) sink[0] = 1.f; } };
struct EpiGlu {
    static constexpr bool PERM = true, AFTER_DRAIN = false, PERM_A = false;
    const bf16_t* Gs; const float* bias; bf16_t* O; int ldo, ooff;
    __device__ __forceinline__ void operator()(const f32x4 (&acc)[2][2][4][2], const Unit& u, int wr, int wc, int fr, int fq) const {
        const int row0 = u.pm * BM + wr * 64 + fr, col0 = u.pn * BM + wc * 32 + 8 * fq;
        f32x4 bs[2][2];
#pragma unroll
        for (int bj = 0; bj < 2; ++bj) { bs[bj][0] = *(const f32x4*)(bias + col0 + bj * HALF); bs[bj][1] = *(const f32x4*)(bias + col0 + bj * HALF + 4); }
#pragma unroll
        for (int ai = 0; ai < 2; ++ai) { u32x4 gw[4][2];
#pragma unroll
            for (int m = 0; m < 4; ++m)
#pragma unroll
                for (int bj = 0; bj < 2; ++bj) gw[m][bj] = *(const u32x4*)(Gs + (size_t)(row0 + ai * HALF + m * 16) * 512 + col0 + bj * HALF);
#pragma unroll
            for (int m = 0; m < 4; ++m) { const size_t r = (size_t)(row0 + ai * HALF + m * 16);
#pragma unroll
                for (int bj = 0; bj < 2; ++bj) { const int c = col0 + bj * HALF; const f32x4 v0 = acc[ai][bj][m][0] + bs[bj][0], v1 = acc[ai][bj][m][1] + bs[bj][1]; const u32x4 g = gw[m][bj];
                    u32x4 w;
                    w.x = cvt_pk_bf16(__uint_as_float(g.x << 16) * __builtin_amdgcn_rcpf(1.f + __builtin_amdgcn_exp2f(v0[0] * -1.4426950408889634f)), __uint_as_float(g.x & 0xffff0000u) * __builtin_amdgcn_rcpf(1.f + __builtin_amdgcn_exp2f(v0[1] * -1.4426950408889634f)));
                    w.y = cvt_pk_bf16(__uint_as_float(g.y << 16) * __builtin_amdgcn_rcpf(1.f + __builtin_amdgcn_exp2f(v0[2] * -1.4426950408889634f)), __uint_as_float(g.y & 0xffff0000u) * __builtin_amdgcn_rcpf(1.f + __builtin_amdgcn_exp2f(v0[3] * -1.4426950408889634f)));
                    w.z = cvt_pk_bf16(__uint_as_float(g.z << 16) * __builtin_amdgcn_rcpf(1.f + __builtin_amdgcn_exp2f(v1[0] * -1.4426950408889634f)), __uint_as_float(g.z & 0xffff0000u) * __builtin_amdgcn_rcpf(1.f + __builtin_amdgcn_exp2f(v1[1] * -1.4426950408889634f)));
                    w.w = cvt_pk_bf16(__uint_as_float(g.w << 16) * __builtin_amdgcn_rcpf(1.f + __builtin_amdgcn_exp2f(v1[2] * -1.4426950408889634f)), __uint_as_float(g.w & 0xffff0000u) * __builtin_amdgcn_rcpf(1.f + __builtin_amdgcn_exp2f(v1[3] * -1.4426950408889634f)));
                    *(u32x4*)(O + r * ldo + ooff + c) = w; } } }
    }
};
}

constexpr int NP0 = 3, NPL = 11, NPH = NP0 + NPL * DEPTH + 1;
#ifndef MK_N_LAUNCHES
#define MK_N_LAUNCHES 1
#endif
__global__ void __launch_bounds__(NWAVES * 64, 2) mk_fwd(Args args) {
    extern __shared__ __attribute__((aligned(16))) unsigned char lds[];
    Frame F;
    F.lds = (LAS unsigned char*)lds; const int wave0 = __builtin_amdgcn_readfirstlane((int)threadIdx.x >> 6);
    F.tid = threadIdx.x; F.lane = F.tid & 63; F.wave = wave0; F.G = gridDim.x; F.bid = blockIdx.x; F.gw = 0; F.NGW = 0; F.gws = 0; F.gt = 0; F.NGT = 0;
    volatile LAS unsigned* MISC = (volatile LAS unsigned*)(F.lds + MISC_OFF);
    for (int u = F.tid; u < (LDS_BYTES - LDSCTL_OFF) / 4; u += NWAVES * 64) ((LAS unsigned*)(F.lds + LDSCTL_OFF))[u] = 0u;
    __syncthreads();
    const int lo = args.ph_lo, hi = args.ph_hi;
    unsigned* barw = (unsigned*)(args.ws + WS_CTL) + CW_BAR;
    XcdBarrier bar; bar.bar = barw; bar.x = 0; bar.st = nullptr;
    if (hi - lo > 1) bar = xcd_barrier_post(barw, MISC + 8);
#define IN(k) (lo <= (k) && (k) < hi)
#define FRESH() do { int w_ = wave0, b_ = (int)blockIdx.x, g_ = (int)gridDim.x, t_; asm volatile("" : "+s"(w_), "+s"(b_), "+s"(g_)); asm volatile("v_mbcnt_lo_u32_b32 %0, -1, 0\n\tv_mbcnt_hi_u32_b32 %0, -1, %0" : "=v"(t_)); t_ += w_ * 64; \
    F.wave = w_; F.bid = b_; F.G = g_; F.tid = t_; F.lane = t_ & 63; F.gw = b_ * NWAVES + w_; F.NGW = g_ * NWAVES; F.gws = w_ * g_ + b_; F.gt = b_ * (NWAVES * 64) + t_; F.NGT = g_ * NWAVES * 64; } while (0)
#define SEAM(k) do { if ((k) + 1 < hi) xcd_barrier(bar); } while (0)
#ifndef REP_MASK
#define REP_MASK 0
#endif
#define REP(kind) for (int rep_##kind = 0; rep_##kind < ((REP_MASK >> (kind)) & 1) + 1; ++rep_##kind)
#define PB() Args pa = args; { size_t z_ = 0; asm volatile("" : "+s"(z_)); pa.ws = args.ws + z_; } unsigned char* const ws = pa.ws
    if (IN(0)) REP(8) { PB(); FRESH(); REP(16) { p0a(F, pa); FRESH(); } REP(17) { p0a_conv(F, pa); FRESH(); } SEAM(0); }
    if (IN(1)) REP(9) { PB(); FRESH(); REP(10) { p0b_conv(F, pa); FRESH(); p0b(F, pa); FRESH(); } REP(11) { s5_tables(F, pa); } SEAM(1); }
    if (IN(2)) REP(12) { PB(); FRESH(); p0c(F, pa); SEAM(2); }
#pragma unroll 1
    for (int l = 0; l < DEPTH; ++l) {
        const int pb = NP0 + NPL * l; const bool last = l == DEPTH - 1;
        if (IN(pb + 0)) REP(1) { PB(); FRESH();
            pg8::Gemm g{(const bf16*)(ws + WS_A), w_in_t(ws, l), MA, N_IN, DM, DM}; pg8::StaticOrder S; S.init(MA, N_IN, F.G, F.bid);
            { const float* RC = (const float*)(ws + WS_ROPE); LAS float* tab = (LAS float*)(F.lds + ROPE_OFF);
              for (int i = F.tid; i < 2 * 64 * 32; i += NWAVES * 64) { const int cs = i >> 11, p = (i >> 5) & 63, j = i & 31; tab[cs * 64 * ROPE_STRIDE + p * ROPE_STRIDE + j] = RC[cs * SEQ * 32 + (j < 16 ? p * 64 : p) * 32 + j]; }
              WG_BAR(); }
            pg8::EpiIn E{(bf16*)(ws + WS_Z), (const float*)(ws + WS_RSTD), (const float*)(ws + WS_SHW) + (size_t)l * 5 * NSH, (const LAS float*)(F.lds + ROPE_OFF)};
            pg8::gemm_phase<pg8::EpiIn, pg8::StaticOrder, true, true>(F.lds + RING_OFF, g, S, E, F.wave);
            SEAM(pb + 0); }
        if (IN(pb + 1)) REP(2) { PB(); FRESH(); s5_chunk_states(F, pa, l); attn_phase(F, pa, l, !last); SEAM(pb + 1); }
        if (IN(pb + 2)) REP(3) { PB(); FRESH(); s5_carries(F, pa, l); gmlp_phase(F, pa, l, !last); if (!last) { FRESH(); conv_next_a(F, pa, l + 1, 0, 0, 120); } SEAM(pb + 2); }
        if (IN(pb + 3)) REP(4) { PB(); FRESH(); s5_outputs(F, pa, l, !last); SEAM(pb + 3); }
        if (IN(pb + 4)) REP(5) { PB(); FRESH();
            pg8::Gemm g{(const bf16*)(ws + WS_GS), w_glu_t(ws, l), MA, SSM_W, SSM_W, SSM_W}; pg8::StaticOrder S; S.init(MA, SSM_W, F.G, F.bid);
            pg8::EpiGlu E{(const bf16*)(ws + WS_GS), pa.in[I_BGLU] + l * SSM_W, (bf16*)(ws + WS_CAT), DM, 1024};
            pg8::gemm_phase<pg8::EpiGlu, pg8::StaticOrder, true, true>(F.lds + RING_OFF, g, S, E, F.wave);
            if (!last) { FRESH(); conv_next_a(F, pa, l + 1, 1, 136, 120); }
            SEAM(pb + 4); }
        if (IN(pb + 5)) { PB(); FRESH();
            { pg8::Gemm g{(const bf16*)(ws + WS_CAT), w_out_t(ws, l), ML, DM, DM, DM}; pg8::StaticOrder S; S.init(ML, DM, F.G, F.bid);
              pg8::EpiRes E{(float*)(ws + WS_XS), l == 0 ? pa.in[I_X] : (const float*)(ws + WS_XS), (const float*)(ws + WS_XS), (const float*)(ws + WS_MOD) + (size_t)l * 5 * NMOD + 2 * DM, (const float*)(ws + WS_GSV) + (size_t)(l * 2 + 1) * 5 * DM, (bf16*)(ws + WS_A), (float*)(ws + WS_SSQ) + (size_t)MA * 32};
              pg8::gemm_phase<pg8::EpiRes, pg8::StaticOrder, true, true>(F.lds + RING_OFF, g, S, E, F.wave); }
            if (!last) { FRESH();
              pg8::Gemm g{(const bf16*)(ws + WS_CAT), w_out_t(ws, l), MA, DM, 256, DM}; pg8::PieceOrder S{F.bid, F.G, 256, 8, 512, 0};
              pg8::EpiSlab E{(float*)(ws + WS_SLAB)};
              pg8::gemm_phase<pg8::EpiSlab, pg8::PieceOrder, true, true>(F.lds + RING_OFF, g, S, E, F.wave); }
            SEAM(pb + 5); }
        if (IN(pb + 6)) { PB(); FRESH(); lat_rstd(F, pa, 0); if (!last) ctx_reduce(F, pa, l, 0); SEAM(pb + 6); }
        if (IN(pb + 7)) REP(6) { PB(); FRESH();
            pg8::Gemm g{(const bf16*)(ws + WS_A), w_up_t(ws, l), MA, NUP, DM, DM}; pg8::StaticOrder S; S.init(last ? ML : MA, NUP, F.G, F.bid);
            pg8::EpiUpConv E{(bf16*)(ws + WS_ACT), (const float*)(ws + WS_RSTD) + MA, (const float*)(ws + WS_SHW) + (size_t)l * 5 * NSH + N_IN, pa.in[I_CW] + (size_t)l * 3 * DFF, pa.in[I_CB] + (size_t)l * DFF,
                                (float*)(ws + WS_EG), (float*)(ws + WS_EV), (LAS float*)(F.lds + EDG_OFF)};
            pg8::gemm_phase<pg8::EpiUpConv, pg8::StaticOrder, true, true>(F.lds + RING_OFF, g, S, E, F.wave);
            SEAM(pb + 7); }
        if (IN(pb + 7) && ((REP_MASK >> 13) & 1)) { PB(); FRESH();
            pg8::Gemm g{(const bf16*)(ws + WS_A), w_up_t(ws, l), MA, NUP, DM, DM}; pg8::StaticOrder S; S.init(MA, NUP, F.G, F.bid);
            pg8::EpiNone E{(float*)(ws + WS_EG)};
            pg8::gemm_phase<pg8::EpiNone, pg8::StaticOrder, true, true>(F.lds + RING_OFF, g, S, E, F.wave);
            xcd_barrier(bar); }
        if (IN(pb + 8)) REP(7) { PB(); FRESH(); conv_fixup(F, pa, l); SEAM(pb + 8); }
        if (IN(pb + 9)) { PB(); FRESH();
            { pg8::Gemm g{(const bf16*)(ws + WS_ACT), w_dn_t(ws, l), ML, DM, DFF, DFF, 1}; pg8::StaticOrder S; S.init(ML, DM, F.G, F.bid);
              pg8::EpiRes E{(float*)(ws + WS_XS), (const float*)(ws + WS_XS), (const float*)(ws + WS_XS), (const float*)(ws + WS_MOD) + (size_t)l * 5 * NMOD + 5 * DM, last ? nullptr : (const float*)(ws + WS_GSV) + (size_t)((l + 1) * 2) * 5 * DM, (bf16*)(ws + WS_A), (float*)(ws + WS_SSQ)};
              pg8::gemm_phase<pg8::EpiRes, pg8::StaticOrder, true, true>(F.lds + RING_OFF, g, S, E, F.wave); }
            if (!last) { FRESH();
              pg8::Gemm g{(const bf16*)(ws + WS_ACT), w_dn_t(ws, l), MA, DM, 640, DFF, 1}; pg8::PieceOrder S{F.bid, F.G, 256, 8, 0, 1};
              pg8::EpiSlab E{(float*)(ws + WS_SLAB)};
              pg8::gemm_phase<pg8::EpiSlab, pg8::PieceOrder, true, true>(F.lds + RING_OFF, g, S, E, F.wave); }
            SEAM(pb + 9); }
        if (IN(pb + 9) && ((REP_MASK >> 14) & 1)) { PB(); FRESH();
            pg8::Gemm g{(const bf16*)(ws + WS_ACT), w_dn_t(ws, l), ML, DM, DFF, DFF, 1}; pg8::StaticOrder S; S.init(ML, DM, F.G, F.bid);
            pg8::EpiNone E{(float*)(ws + WS_EG)};
            pg8::gemm_phase<pg8::EpiNone, pg8::StaticOrder, true, true>(F.lds + RING_OFF, g, S, E, F.wave);
            xcd_barrier(bar); }
        if (IN(pb + 10) && !last) { PB(); FRESH(); lat_rstd(F, pa, 1); ctx_reduce(F, pa, l, 1); SEAM(pb + 10); }
    }
    if (IN(NPH - 1)) { PB(); FRESH(); final_norm(F, pa); }
#undef IN
#undef SEAM
}

extern "C" void kernel_launch(void* const* d_in, const int* in_sizes, int n_in, void* d_out, int out_size, void* d_ws, size_t ws_size, hipStream_t stream) {
    static int grid = 0;
    if (grid == 0) {
        if (n_in != N_INPUTS || in_sizes[0] != ML * DM || out_size != ML * DM || ws_size < WS_END2) {
            fprintf(stderr, "kernel_launch: unexpected shapes (n_in %d, in0 %d, out %d, ws %zu need %zu); nothing launched\n", n_in, n_in > 0 ? in_sizes[0] : -1, out_size, ws_size, (size_t)WS_END2); grid = -1; return; }
        int dev = 0, cus = 0, per_cu = 0;
        if (hipGetDevice(&dev) != hipSuccess || hipDeviceGetAttribute(&cus, hipDeviceAttributeMultiprocessorCount, dev) != hipSuccess) { fprintf(stderr, "kernel_launch: device query failed\n"); grid = -1; return; }
        if (hipFuncSetAttribute((const void*)mk_fwd, hipFuncAttributeMaxDynamicSharedMemorySize, LDS_BYTES) != hipSuccess) { fprintf(stderr, "kernel_launch: hipFuncSetAttribute failed\n"); grid = -1; return; }
        if (hipOccupancyMaxActiveBlocksPerMultiprocessor(&per_cu, (const void*)mk_fwd, NWAVES * 64, LDS_BYTES) != hipSuccess || per_cu < 1) { fprintf(stderr, "kernel_launch: occupancy query says %d blocks per CU\n", per_cu); }
        (void)hipGetLastError();
        grid = cus;
    }
    if (grid < 0) return;
    if (hipMemsetAsync((char*)d_ws + WS_CTL, 0, CTL_ZERO_BYTES, stream) != hipSuccess) { fprintf(stderr, "kernel_launch: memset failed\n"); return; }
    Args a{};
    for (int i = 0; i < N_INPUTS; ++i) a.in[i] = (const float*)d_in[i];
    a.out = (float*)d_out; a.ws = (unsigned char*)d_ws;
    if (MK_N_LAUNCHES == 1) { a.ph_lo = 0; a.ph_hi = NPH; hipLaunchKernelGGL(mk_fwd, dim3(grid), dim3(NWAVES * 64), LDS_BYTES, stream, a); }
    else { for (int p = 0; p < NPH; ++p) { a.ph_lo = p; a.ph_hi = p + 1; hipLaunchKernelGGL(mk_fwd, dim3(grid), dim3(NWAVES * 64), LDS_BYTES, stream, a); } }
    const hipError_t le = hipPeekAtLastError();
    if (le != hipSuccess) fprintf(stderr, "kernel_launch: launch failed: %s\n", hipGetErrorName(le));
}
```
